# Optimizing an MI355X kernel written in HIP

```python
import jax, jax.numpy as jnp
from jax import lax
import numpy as np

D_MODEL = 1024
BATCH = 16
SEQ = 2048
DEPTH = 1

MIX_WIDTH = D_MODEL
ATTN_WIDTH = MIX_WIDTH // 2
CONV_WIDTH = MIX_WIDTH - ATTN_WIDTH
HEAD_DIM = 64
N_ATTN_HEADS = ATTN_WIDTH // HEAD_DIM
N_CONV_GROUPS = CONV_WIDTH // HEAD_DIM
CONV_KERNEL = 31
D_FF = 4 * D_MODEL
Q_BLOCK = 128
EPS = 1e-6
IN_COLS = 3 * ATTN_WIDTH + 2 * CONV_WIDTH + N_ATTN_HEADS
SPLITS = (ATTN_WIDTH, 2 * ATTN_WIDTH, 3 * ATTN_WIDTH,
          3 * ATTN_WIDTH + CONV_WIDTH, 3 * ATTN_WIDTH + 2 * CONV_WIDTH)

kernel_name = "hymba_fox_conformer_conv_hybrid"


def rmsnorm(x, g):
    xf = x.astype(jnp.float32)
    y = xf * lax.rsqrt(jnp.mean(xf * xf, axis=-1, keepdims=True) + EPS)
    return (y * g.astype(jnp.float32)).astype(x.dtype)


def layernorm(x, g, b):
    xf = x.astype(jnp.float32)
    mu = jnp.mean(xf, axis=-1, keepdims=True)
    xc = xf - mu
    y = xc * lax.rsqrt(jnp.mean(xc * xc, axis=-1, keepdims=True) + EPS)
    return (y * g.astype(jnp.float32) + b.astype(jnp.float32)).astype(x.dtype)


def headwise_rmsnorm(y, g, n_groups):
    B, S, _ = y.shape
    yh = y.reshape(B, S, n_groups, HEAD_DIM)
    out = rmsnorm(yh, g.reshape(n_groups, HEAD_DIM))
    return out.reshape(B, S, n_groups * HEAD_DIM)


def fox_attention(q, k, v, log_f):
    B, S, H, Dh = q.shape
    scale = Dh ** -0.5
    qh = jnp.transpose(q, (0, 2, 1, 3))
    kh = jnp.transpose(k, (0, 2, 1, 3))
    vh = jnp.transpose(v, (0, 2, 1, 3))
    c = jnp.transpose(jnp.cumsum(log_f.astype(jnp.float32), axis=1), (0, 2, 1))
    outs = []
    for blk in range(S // Q_BLOCK):
        q0 = blk * Q_BLOCK
        q1 = q0 + Q_BLOCK
        qb = qh[:, :, q0:q1]
        kb = kh[:, :, :q1]
        vb = vh[:, :, :q1]
        s = jnp.einsum('bhqd,bhkd->bhqk', qb, kb, preferred_element_type=jnp.float32) * scale
        s = s + c[:, :, q0:q1, None] - c[:, :, None, :q1]
        qpos = q0 + jnp.arange(Q_BLOCK)
        kpos = jnp.arange(q1)
        s = jnp.where(kpos[None, :] <= qpos[:, None], s, -jnp.inf)
        p = jax.nn.softmax(s, axis=-1)
        outs.append(jnp.einsum('bhqk,bhkd->bhqd', p.astype(vb.dtype), vb))
    o = jnp.concatenate(outs, axis=2)
    return jnp.transpose(o, (0, 2, 1, 3))


def causal_depthwise_conv(u, w, b):
    K, C = w.shape
    y = lax.conv_general_dilated(
        u, w[:, None, :].astype(u.dtype), window_strides=(1,), padding=[(K - 1, 0)],
        dimension_numbers=('NWC', 'WIO', 'NWC'), feature_group_count=C)
    return y + b.astype(u.dtype)


def setup_inputs(seed: int = 0) -> dict:
    key = jax.random.key(seed)
    ks = jax.random.split(key, 20)
    f32 = jnp.float32
    L = DEPTH
    nrm = lambda k, shape, s: jax.random.normal(k, shape, f32) * s
    x = jax.random.normal(ks[0], (BATCH, SEQ, D_MODEL), f32)
    norm_mix_g = 1.0 + nrm(ks[1], (L, D_MODEL), 0.02)
    w_in = nrm(ks[2], (L, D_MODEL, IN_COLS), D_MODEL ** -0.5)
    b_forget = jnp.linspace(1.0, 4.0, N_ATTN_HEADS, dtype=f32)[None, :] + nrm(ks[3], (L, N_ATTN_HEADS), 0.1)
    conv_dw_w = nrm(ks[4], (L, CONV_KERNEL, CONV_WIDTH), CONV_KERNEL ** -0.5)
    conv_dw_b = nrm(ks[5], (L, CONV_WIDTH), 0.02)
    conv_ln_g = 1.0 + nrm(ks[6], (L, CONV_WIDTH), 0.02)
    conv_ln_b = nrm(ks[7], (L, CONV_WIDTH), 0.02)
    w_conv_pw = nrm(ks[8], (L, CONV_WIDTH, CONV_WIDTH), CONV_WIDTH ** -0.5)
    b_conv_pw = nrm(ks[9], (L, CONV_WIDTH), 0.02)
    attn_out_g = 1.0 + nrm(ks[10], (L, ATTN_WIDTH), 0.02)
    conv_out_g = 1.0 + nrm(ks[11], (L, CONV_WIDTH), 0.02)
    w_out = nrm(ks[12], (L, MIX_WIDTH, D_MODEL), MIX_WIDTH ** -0.5)
    norm_ffn_g = 1.0 + nrm(ks[13], (L, D_MODEL), 0.02)
    w_ffn_up = nrm(ks[14], (L, D_MODEL, D_FF), D_MODEL ** -0.5)
    w_ffn_down = nrm(ks[15], (L, D_FF, D_MODEL), D_FF ** -0.5)
    norm_final_g = 1.0 + nrm(ks[16], (D_MODEL,), 0.02)
    return {"x": x, "norm_mix_g": norm_mix_g, "w_in": w_in, "b_forget": b_forget,
            "conv_dw_w": conv_dw_w, "conv_dw_b": conv_dw_b, "conv_ln_g": conv_ln_g,
            "conv_ln_b": conv_ln_b, "w_conv_pw": w_conv_pw, "b_conv_pw": b_conv_pw,
            "attn_out_g": attn_out_g, "conv_out_g": conv_out_g, "w_out": w_out,
            "norm_ffn_g": norm_ffn_g, "w_ffn_up": w_ffn_up, "w_ffn_down": w_ffn_down,
            "norm_final_g": norm_final_g}


def reference(x, norm_mix_g, w_in, b_forget, conv_dw_w, conv_dw_b, conv_ln_g, conv_ln_b,
              w_conv_pw, b_conv_pw, attn_out_g, conv_out_g, w_out, norm_ffn_g,
              w_ffn_up, w_ffn_down, norm_final_g):
    B, S, _ = x.shape
    for l in range(DEPTH):
        h = rmsnorm(x, norm_mix_g[l])
        proj = h @ w_in[l]
        q, k, v, ga, gb, f_logit = jnp.split(proj, SPLITS, axis=-1)
        log_f = jax.nn.log_sigmoid(f_logit.astype(jnp.float32) + b_forget[l].astype(jnp.float32))
        hs = (B, S, N_ATTN_HEADS, HEAD_DIM)
        attn = fox_attention(q.reshape(hs), k.reshape(hs), v.reshape(hs), log_f)
        attn = headwise_rmsnorm(attn.reshape(B, S, ATTN_WIDTH), attn_out_g[l], N_ATTN_HEADS)
        u = ga * jax.nn.sigmoid(gb)
        u = causal_depthwise_conv(u, conv_dw_w[l], conv_dw_b[l])
        u = jax.nn.silu(layernorm(u, conv_ln_g[l], conv_ln_b[l]))
        u = u @ w_conv_pw[l] + b_conv_pw[l]
        conv = headwise_rmsnorm(u, conv_out_g[l], N_CONV_GROUPS)
        x = x + jnp.concatenate([attn, conv], axis=-1) @ w_out[l]
        h = rmsnorm(x, norm_ffn_g[l])
        x = x + jnp.square(jax.nn.relu(h @ w_ffn_up[l])) @ w_ffn_down[l]
    return rmsnorm(x, norm_final_g)
```

```cpp
#include <hip/hip_runtime.h>
#include <cstdio>
#include <cstdint>

namespace nv {
constexpr int D_MODEL = 1024, BATCH = 16, SEQ = 2048, M = BATCH * SEQ;
constexpr int AW = 512, CW = 512, HD = 64, NH = 8, NG = 8, CK = 31, DFF = 4096;
constexpr int IN_COLS = 3 * AW + 2 * CW + NH;
constexpr float EPS = 1e-6f;

__device__ __forceinline__ float wave_sum(float v) {
#pragma unroll
    for (int o = 1; o < 64; o <<= 1) v += __shfl_xor(v, o);
    return v;
}

__global__ void __launch_bounds__(256) k_rmsnorm(const float* __restrict__ x, const float* __restrict__ g, float* __restrict__ out, int rows) {
    const int wave = (blockIdx.x * 256 + threadIdx.x) >> 6, lane = threadIdx.x & 63;
    if (wave >= rows) return;
    const float* xr = x + (size_t)wave * D_MODEL; float* orow = out + (size_t)wave * D_MODEL;
    float v[16]; float s = 0.f;
#pragma unroll
    for (int j = 0; j < 16; ++j) { v[j] = xr[lane + 64 * j]; s += v[j] * v[j]; }
    s = wave_sum(s);
    const float r = 1.0f / sqrtf(s * (1.0f / D_MODEL) + EPS);
#pragma unroll
    for (int j = 0; j < 16; ++j) orow[lane + 64 * j] = v[j] * r * g[lane + 64 * j];
}

__global__ void __launch_bounds__(256) k_gemm(const float* __restrict__ A, int lda, const float* __restrict__ B, int ldb, float* C, int ldc,
                                              int Mr, int N, int K, int mode, const float* __restrict__ bias, const float* res, int ldr) {
    __shared__ float As[16][64 + 4];
    __shared__ float Bs[16][64 + 4];
    const int tid = threadIdx.x, tx = tid & 15, ty = tid >> 4;
    const int m0 = blockIdx.y * 64, n0 = blockIdx.x * 64;
    float acc[4][4] = {};
    for (int k0 = 0; k0 < K; k0 += 16) {
#pragma unroll
        for (int i = 0; i < 4; ++i) { const int e = tid + 256 * i, m = e >> 4, k = e & 15; As[k][m] = A[(size_t)(m0 + m) * lda + k0 + k]; }
#pragma unroll
        for (int i = 0; i < 4; ++i) { const int e = tid + 256 * i, k = e >> 6, n = e & 63; Bs[k][n] = (n0 + n < N) ? B[(size_t)(k0 + k) * ldb + n0 + n] : 0.f; }
        __syncthreads();
#pragma unroll
        for (int k = 0; k < 16; ++k) {
            float a[4], b[4];
#pragma unroll
            for (int i = 0; i < 4; ++i) { a[i] = As[k][ty * 4 + i]; b[i] = Bs[k][tx * 4 + i]; }
#pragma unroll
            for (int i = 0; i < 4; ++i)
#pragma unroll
                for (int j = 0; j < 4; ++j) acc[i][j] += a[i] * b[j];
        }
        __syncthreads();
    }
#pragma unroll
    for (int i = 0; i < 4; ++i)
#pragma unroll
        for (int j = 0; j < 4; ++j) {
            const int m = m0 + ty * 4 + i, n = n0 + tx * 4 + j;
            if (n < N) {
                float v = acc[i][j]; if (bias) v += bias[n];
                float* c = C + (size_t)m * ldc + n;
                if (mode == 0) *c = v; else if (mode == 1) *c += v; else if (mode == 2) { v = v > 0.f ? v : 0.f; *c = v * v; } else *c = res[(size_t)m * ldr + n] + v;
            }
        }
}

__global__ void k_cumsum(const float* __restrict__ proj, const float* __restrict__ bf, float* __restrict__ c) {
    const int i = blockIdx.x * blockDim.x + threadIdx.x; if (i >= BATCH * NH) return;
    const int b = i / NH, h = i % NH; double acc = 0.0;
    for (int t = 0; t < SEQ; ++t) {
        const float xv = proj[(size_t)(b * SEQ + t) * IN_COLS + 2560 + h] + bf[h];
        const float ls = fminf(xv, 0.f) - log1pf(expf(-fabsf(xv)));
        acc += (double)ls; c[(size_t)i * SEQ + t] = (float)acc;
    }
}

__global__ void __launch_bounds__(64) k_attn(const float* __restrict__ proj, const float* __restrict__ c, float* __restrict__ out, int ldo) {
    const int bh = blockIdx.y, b = bh / NH, h = bh % NH, t = blockIdx.x * 64 + threadIdx.x;
    const float* base = proj + (size_t)b * SEQ * IN_COLS;
    float q[64], o[64];
#pragma unroll
    for (int d = 0; d < 64; ++d) { q[d] = base[(size_t)t * IN_COLS + h * 64 + d] * 0.125f; o[d] = 0.f; }
    const float* cc = c + (size_t)bh * SEQ; const float ct = cc[t];
    float m = -INFINITY, l = 0.f;
    const int tmax = blockIdx.x * 64 + 63;
    for (int s = 0; s <= tmax; ++s) {
        const float* kr = base + (size_t)s * IN_COLS + AW + h * 64; const float* vr = base + (size_t)s * IN_COLS + 2 * AW + h * 64;
        float sc = 0.f;
#pragma unroll
        for (int d = 0; d < 64; ++d) sc += q[d] * kr[d];
        sc += ct - cc[s];
        if (s <= t) {
            const float mn = fmaxf(m, sc), f = expf(m - mn), p = expf(sc - mn);
            l = l * f + p;
#pragma unroll
            for (int d = 0; d < 64; ++d) o[d] = o[d] * f + p * vr[d];
            m = mn;
        }
    }
    const float rl = 1.0f / l;
#pragma unroll
    for (int d = 0; d < 64; ++d) out[(size_t)(b * SEQ + t) * ldo + h * 64 + d] = o[d] * rl;
}

__global__ void __launch_bounds__(256) k_headnorm(const float* in, int ldi, const float* __restrict__ g, float* out, int ldo, int ocol) {
    const int wave = (blockIdx.x * 256 + threadIdx.x) >> 6, lane = threadIdx.x & 63; if (wave >= M) return;
    for (int grp = 0; grp < 8; ++grp) {
        const float v = in[(size_t)wave * ldi + grp * 64 + lane];
        const float s = wave_sum(v * v);
        out[(size_t)wave * ldo + ocol + grp * 64 + lane] = v * (1.0f / sqrtf(s * (1.0f / 64.f) + EPS)) * g[grp * 64 + lane];
    }
}

__global__ void __launch_bounds__(512) k_conv(const float* __restrict__ proj, const float* __restrict__ w, const float* __restrict__ bdw,
                                              const float* __restrict__ lg, const float* __restrict__ lb, float* __restrict__ U) {
    __shared__ float red[16];
    const int row = blockIdx.x, b = row / SEQ, t = row % SEQ, ch = threadIdx.x;
    float acc = bdw[ch];
    for (int j = 0; j < CK; ++j) { const int tt = t - (CK - 1) + j; if (tt < 0) continue;
        const float* pr = proj + (size_t)(b * SEQ + tt) * IN_COLS; const float ga = pr[1536 + ch], gb = pr[2048 + ch];
        acc += w[j * CW + ch] * (ga * (1.0f / (1.0f + expf(-gb)))); }
    float s = wave_sum(acc); if ((ch & 63) == 0) red[ch >> 6] = s; __syncthreads();
    float tot = 0.f; for (int i = 0; i < 8; ++i) tot += red[i];
    const float mean = tot * (1.0f / CW), dv = acc - mean; __syncthreads();
    s = wave_sum(dv * dv); if ((ch & 63) == 0) red[8 + (ch >> 6)] = s; __syncthreads();
    tot = 0.f; for (int i = 0; i < 8; ++i) tot += red[8 + i];
    const float y = dv * (1.0f / sqrtf(tot * (1.0f / CW) + EPS)) * lg[ch] + lb[ch];
    U[(size_t)row * CW + ch] = y * (1.0f / (1.0f + expf(-y)));
}

static void gemm(hipStream_t st, const float* A, int lda, const float* B, int ldb, float* C, int ldc, int Mr, int N, int K, int mode, const float* bias, const float* res, int ldr) {
    hipLaunchKernelGGL(k_gemm, dim3((N + 63) / 64, Mr / 64), dim3(256), 0, st, A, lda, B, ldb, C, ldc, Mr, N, K, mode, bias, res, ldr);
}

static void forward(void* const* d_in, void* d_out, void* d_ws, hipStream_t st) {
    const float* x = (const float*)d_in[0]; const float* norm_mix_g = (const float*)d_in[1]; const float* w_in = (const float*)d_in[2]; const float* b_forget = (const float*)d_in[3];
    const float* conv_dw_w = (const float*)d_in[4]; const float* conv_dw_b = (const float*)d_in[5]; const float* conv_ln_g = (const float*)d_in[6]; const float* conv_ln_b = (const float*)d_in[7];
    const float* w_conv_pw = (const float*)d_in[8]; const float* b_conv_pw = (const float*)d_in[9]; const float* attn_out_g = (const float*)d_in[10]; const float* conv_out_g = (const float*)d_in[11];
    const float* w_out = (const float*)d_in[12]; const float* norm_ffn_g = (const float*)d_in[13]; const float* w_up = (const float*)d_in[14]; const float* w_down = (const float*)d_in[15];
    const float* norm_final_g = (const float*)d_in[16];
    float* out = (float*)d_out; char* ws = (char*)d_ws;
    const size_t MB = 1u << 20;
    float* PROJ = (float*)(ws);
    float* CAT = (float*)(ws + 324 * MB);
    float* CUM = (float*)(ws + 452 * MB);
    float* H0 = out;
    hipLaunchKernelGGL(k_rmsnorm, dim3(M / 4), dim3(256), 0, st, x, norm_mix_g, H0, M);
    gemm(st, H0, D_MODEL, w_in, IN_COLS, PROJ, IN_COLS, M, IN_COLS, D_MODEL, 0, nullptr, nullptr, 0);
    hipLaunchKernelGGL(k_cumsum, dim3(1), dim3(128), 0, st, PROJ, b_forget, CUM);
    float* T0 = out;
    float* T1 = out + (size_t)M * 512;
    hipLaunchKernelGGL(k_attn, dim3(SEQ / 64, BATCH * NH), dim3(64), 0, st, PROJ, CUM, T0, 512);
    hipLaunchKernelGGL(k_headnorm, dim3(M / 4), dim3(256), 0, st, T0, 512, attn_out_g, CAT, 1024, 0);
    hipLaunchKernelGGL(k_conv, dim3(M), dim3(512), 0, st, PROJ, conv_dw_w, conv_dw_b, conv_ln_g, conv_ln_b, T0);
    gemm(st, T0, 512, w_conv_pw, 512, T1, 512, M, 512, 512, 0, b_conv_pw, nullptr, 0);
    hipLaunchKernelGGL(k_headnorm, dim3(M / 4), dim3(256), 0, st, T1, 512, conv_out_g, CAT, 1024, 512);
    float* X1 = (float*)(ws);
    float* HN = (float*)(ws + 128 * MB);
    gemm(st, CAT, 1024, w_out, 1024, X1, 1024, M, 1024, 1024, 3, nullptr, x, 1024);
    hipLaunchKernelGGL(k_rmsnorm, dim3(M / 4), dim3(256), 0, st, X1, norm_ffn_g, HN, M);
    float* HCH = out;
    for (int c = 0; c < 4; ++c) {
        gemm(st, HN, 1024, w_up + c * 1024, DFF, HCH, 1024, M, 1024, 1024, 2, nullptr, nullptr, 0);
        gemm(st, HCH, 1024, w_down + (size_t)c * 1024 * 1024, 1024, X1, 1024, M, 1024, 1024, 1, nullptr, nullptr, 0);
    }
    hipLaunchKernelGGL(k_rmsnorm, dim3(M / 4), dim3(256), 0, st, X1, norm_final_g, out, M);
}
}

extern "C" void kernel_launch(void* const* d_in, const int* in_sizes, int n_in, void* d_out, int out_size, void* d_ws, size_t ws_size, hipStream_t stream) {
    (void)in_sizes; (void)n_in; (void)out_size; (void)ws_size;
    nv::forward(d_in, d_out, d_ws, stream);
}
```

```cpp
#include <hip/hip_runtime.h>
#include <cstdio>
#include <cstdint>
namespace pg8 {
#define PG8_LAS __attribute__((address_space(3)))
typedef unsigned short bf16_t;
typedef short bf16x8 __attribute__((ext_vector_type(8)));
typedef float f32x4 __attribute__((ext_vector_type(4)));
typedef unsigned u32x4 __attribute__((ext_vector_type(4)));
constexpr int BM = 256, BK = 64, HALF = 128, HTB = HALF * BK * 2  , STAGE_BYTES = 8 * HTB, NXCD = 8, WGM = 8;

__host__ __device__ __forceinline__ int lds_byte(int r, int c) { const int st = (r >> 4) * 2 + (c >> 5), rr = r & 15, cc = c & 31, ob = rr * 64 + cc * 2; return st * 1024 + (ob ^ (((ob >> 9) & 1) << 5)); }
__host__ __device__ __forceinline__ void stage_rc(int b, int& R, int& C) { const int st = b / 1024, sb = b % 1024, swz = sb ^ (((sb >> 9) & 1) << 5); R = (st >> 1) * 16 + swz / 64; C = (st & 1) * 32 + (swz % 64) / 2; }
__host__ __device__ __forceinline__ int perm32(int rho) { const int n = rho >> 4, i = rho & 15; return 8 * (i >> 2) + 4 * n + (i & 3); }

struct Unit { int pm, pn; };
struct Gemm { const bf16_t* A; const bf16_t* Bt; int M, N, K; };

struct StaticOrder {
    int nM, nN, nwg, G, c;
    __host__ __device__ void init(int M, int N, int G_, int c_) { nM = M / BM; nN = N / BM; nwg = nM * nN; G = G_; c = c_; }
    __host__ __device__ bool next(int i, Unit& u) const {
        const long L = (long)i * G + c; if (L >= nwg) return false;
        int wgid = (int)L; { const int q = nwg / NXCD, r = nwg % NXCD, xcd = wgid % NXCD, off = wgid / NXCD; wgid = (xcd < r ? xcd * (q + 1) : r * (q + 1) + (xcd - r) * q) + off; }
        const int nig = WGM * nN, gid = wgid / nig, fm = gid * WGM, gsz = (nM - fm) < WGM ? (nM - fm) : WGM;
        u.pm = fm + ((wgid % nig) % gsz); u.pn = (wgid % nig) / gsz; return true;
    }
    __device__ __forceinline__ void a_ready(const Unit&) const {}
    __device__ __forceinline__ void done(const Unit&) const {}
};

__device__ __forceinline__ unsigned cvt_pk_bf16(float lo, float hi) { unsigned r; asm volatile("v_cvt_pk_bf16_f32 %0, %1, %2" : "=v"(r) : "v"(lo), "v"(hi)); return r; }
typedef float f32x2 __attribute__((ext_vector_type(2)));
constexpr float LOG2E_F = 1.4426950408889634f;
__device__ __forceinline__ float sigmoid_f(float x) { return __builtin_amdgcn_rcpf(1.0f + __builtin_amdgcn_exp2f(-x * LOG2E_F)); }
#define PG8_LDSBAR() do { asm volatile("s_waitcnt lgkmcnt(0)" ::: "memory"); __builtin_amdgcn_s_barrier(); asm volatile("" ::: "memory"); } while (0)

struct EpiInProj {
    static constexpr bool PERM = true, AFTER_DRAIN = false;
    bf16_t* QKV; size_t stride; bf16_t* U; float qscale;
    __device__ __forceinline__ void operator()(const f32x4 (&acc)[2][2][4][2], const Unit& u, int wr, int wc, int fr, int fq) const {
        const int row0 = u.pm * BM + wr * 64 + fr;
        if (u.pn < 6) {
            const int t = u.pn >> 1; bf16_t* base = QKV + (size_t)t * stride; const float sc = (t == 0) ? qscale : 1.f;
            const int col0 = (u.pn & 1) * BM + wc * 32 + 8 * fq;
#pragma unroll
            for (int ai = 0; ai < 2; ++ai)
#pragma unroll
                for (int m = 0; m < 4; ++m) { bf16_t* rowp = base + (size_t)(row0 + ai * HALF + m * 16) * 512 + col0;
#pragma unroll
                    for (int bj = 0; bj < 2; ++bj) { const f32x4 v0 = acc[ai][bj][m][0] * sc, v1 = acc[ai][bj][m][1] * sc;
                        u32x4 w; w.x = cvt_pk_bf16(v0[0], v0[1]); w.y = cvt_pk_bf16(v0[2], v0[3]); w.z = cvt_pk_bf16(v1[0], v1[1]); w.w = cvt_pk_bf16(v1[2], v1[3]);
                        *(u32x4*)(rowp + bj * HALF) = w; } }
        } else {
            const int col0 = (u.pn - 6) * HALF + wc * 32 + 8 * fq;
#pragma unroll
            for (int ai = 0; ai < 2; ++ai)
#pragma unroll
                for (int m = 0; m < 4; ++m) { bf16_t* rowp = U + (size_t)(row0 + ai * HALF + m * 16) * 512 + col0;
                    f32x4 g0 = acc[ai][0][m][0], g1 = acc[ai][0][m][1]; const f32x4 s0 = acc[ai][1][m][0], s1 = acc[ai][1][m][1];
#pragma unroll
                    for (int e = 0; e < 4; ++e) { g0[e] *= sigmoid_f(s0[e]); g1[e] *= sigmoid_f(s1[e]); }
                    u32x4 w; w.x = cvt_pk_bf16(g0[0], g0[1]); w.y = cvt_pk_bf16(g0[2], g0[3]); w.z = cvt_pk_bf16(g1[0], g1[1]); w.w = cvt_pk_bf16(g1[2], g1[3]);
                    *(u32x4*)rowp = w; }
        }
    }
};
struct EpiRelu2 {
    static constexpr bool PERM = true, AFTER_DRAIN = false;
    bf16_t* O; int ldc;
    __device__ __forceinline__ void operator()(const f32x4 (&acc)[2][2][4][2], const Unit& u, int wr, int wc, int fr, int fq) const {
        const int row0 = u.pm * BM + wr * 64 + fr, col0 = u.pn * BM + wc * 32 + 8 * fq;
#pragma unroll
        for (int ai = 0; ai < 2; ++ai)
#pragma unroll
            for (int m = 0; m < 4; ++m) { bf16_t* rowp = O + (size_t)(row0 + ai * HALF + m * 16) * ldc + col0;
#pragma unroll
                for (int bj = 0; bj < 2; ++bj) { f32x4 v0 = acc[ai][bj][m][0], v1 = acc[ai][bj][m][1];
#pragma unroll
                    for (int e = 0; e < 4; ++e) { const float a = __builtin_fmaxf(v0[e], 0.f), b = __builtin_fmaxf(v1[e], 0.f); v0[e] = a * a; v1[e] = b * b; }
                    u32x4 w; w.x = cvt_pk_bf16(v0[0], v0[1]); w.y = cvt_pk_bf16(v0[2], v0[3]); w.z = cvt_pk_bf16(v1[0], v1[1]); w.w = cvt_pk_bf16(v1[2], v1[3]);
                    *(u32x4*)(rowp + bj * HALF) = w; } }
    }
};
template <int MODE> struct EpiRes {
    static constexpr bool PERM = false, AFTER_DRAIN = false;
    const float* base; float* out; bf16_t* xb; float* ssq; const float* ssq_in; PG8_LAS float* sc; float eps;
    __device__ __forceinline__ void operator()(const f32x4 (&acc)[2][2][4][2], const Unit& u, int wr, int wc, int fr, int fq) const {
        typedef unsigned u32x2v __attribute__((ext_vector_type(2)));
        const int col0 = u.pn * BM + wc * 32 + 4 * fq;
#pragma unroll
        for (int ai = 0; ai < 2; ++ai)
#pragma unroll
            for (int m = 0; m < 4; ++m) { const int r = ai * HALF + wr * 64 + m * 16 + fr; const size_t off = (size_t)(u.pm * BM + r) * 1024 + col0;
                float r2 = 1.f;
                if (MODE == 1) { const f32x4 p = *(const f32x4*)(ssq_in + (size_t)(u.pm * BM + r) * 4); r2 = 1.0f / (((p[0] + p[1]) + (p[2] + p[3])) * (1.0f / 1024.0f) + eps); }
                float ss = 0.f;
#pragma unroll
                for (int bj = 0; bj < 2; ++bj)
#pragma unroll
                    for (int n = 0; n < 2; ++n) { const f32x4 bs = *(const f32x4*)(base + off + bj * HALF + n * 16); const f32x4 o = bs + acc[ai][bj][m][n] * r2;
                        *(f32x4*)(out + off + bj * HALF + n * 16) = o; ss += (o[0] * o[0] + o[1] * o[1]) + (o[2] * o[2] + o[3] * o[3]);
                        if (xb) { u32x2v w; w.x = cvt_pk_bf16(o[0], o[1]); w.y = cvt_pk_bf16(o[2], o[3]); *(u32x2v*)(xb + off + bj * HALF + n * 16) = w; } }
                ss += __shfl_xor(ss, 16); ss += __shfl_xor(ss, 32);
                if (fq == 0) sc[r * 4 + wc] = ss;
                if (m & 1) asm volatile("" ::: "memory"); }
        PG8_LDSBAR();
        const int tid = threadIdx.x;
        if (tid < 256) { const f32x4 p = *(const PG8_LAS f32x4*)(sc + tid * 4); ssq[(size_t)(u.pm * BM + tid) * 4 + u.pn] = (p[0] + p[1]) + (p[2] + p[3]); }
    }
};
struct EpiConvOut {
    static constexpr bool PERM = true, AFTER_DRAIN = true;
    bf16_t* cat; const float* bias; const float* g; float eps;
    __device__ __forceinline__ void fused(f32x4 (&acc)[2][2][4][2], const Unit& u, int wr, int wc, int fr, int fq, PG8_LAS unsigned char* lds, int wid, int lane) const {
        PG8_LAS float* sc = (PG8_LAS float*)lds;
        const int cb = u.pn * BM + wc * 32 + 8 * fq;
        f32x4 gv[2][2];
#pragma unroll
        for (int bj = 0; bj < 2; ++bj)
#pragma unroll
            for (int n = 0; n < 2; ++n) { const f32x4 bv = *(const f32x4*)(bias + cb + bj * HALF + 4 * n); gv[bj][n] = *(const f32x4*)(g + cb + bj * HALF + 4 * n);
#pragma unroll
                for (int ai = 0; ai < 2; ++ai)
#pragma unroll
                    for (int m = 0; m < 4; ++m) acc[ai][bj][m][n] += bv; }
#pragma unroll
        for (int ai = 0; ai < 2; ++ai)
#pragma unroll
            for (int m = 0; m < 4; ++m) { const int r = ai * HALF + wr * 64 + m * 16 + fr;
#pragma unroll
                for (int bj = 0; bj < 2; ++bj) { const f32x4 a = acc[ai][bj][m][0], b = acc[ai][bj][m][1];
                    float s = ((a[0] * a[0] + a[1] * a[1]) + (a[2] * a[2] + a[3] * a[3])) + ((b[0] * b[0] + b[1] * b[1]) + (b[2] * b[2] + b[3] * b[3]));
                    s += __shfl_xor(s, 16); s += __shfl_xor(s, 32);
                    if (fq == 0) sc[(r * 2 + bj) * 4 + wc] = s; } }
        PG8_LDSBAR();
#pragma unroll
        for (int ai = 0; ai < 2; ++ai)
#pragma unroll
            for (int m = 0; m < 4; ++m) { const int r = ai * HALF + wr * 64 + m * 16 + fr; bf16_t* rowp = cat + (size_t)(u.pm * BM + r) * 1024 + 512 + cb;
#pragma unroll
                for (int bj = 0; bj < 2; ++bj) { const float tot = sc[(r * 2 + bj) * 4 + wc] + sc[(r * 2 + bj) * 4 + (wc ^ 1)];
                    const float rs = 1.0f / sqrtf(tot * (1.0f / 64.0f) + eps);
                    const f32x4 v0 = acc[ai][bj][m][0] * rs * gv[bj][0], v1 = acc[ai][bj][m][1] * rs * gv[bj][1];
                    u32x4 w; w.x = cvt_pk_bf16(v0[0], v0[1]); w.y = cvt_pk_bf16(v0[2], v0[3]); w.z = cvt_pk_bf16(v1[0], v1[1]); w.w = cvt_pk_bf16(v1[2], v1[3]);
                    *(u32x4*)(rowp + bj * HALF) = w; } }
    }
};

template <class Epi, class Sched, bool ALIGN_EPI = false, bool SP2 = false>
__device__ __forceinline__ void gemm_phase(PG8_LAS unsigned char* lds, const Gemm g, const Sched& S, const Epi& E) {
    const int tid = threadIdx.x, wid = __builtin_amdgcn_readfirstlane(tid >> 6), lane = tid & 63, wr = wid >> 2, wc = wid & 3, fr = lane & 15, fq = lane >> 4;
    const int K = g.K, nt = K / BK;
    unsigned voffA[2], voffB[2];
#pragma unroll
    for (int i = 0; i < 2; ++i) { int R, C; stage_rc(tid * 16 + i * 8192, R, C); const int Rb = Epi::PERM ? ((R & ~31) + perm32(R & 31)) : R;
        voffA[i] = (unsigned)(R * K + C) * 2u; voffB[i] = (unsigned)(Rb * K + C) * 2u; }
    const size_t kstep = (size_t)(BK * 2);
    const size_t hstep = (size_t)HALF * K * 2;
    const size_t tstep = 2 * hstep;
    const unsigned ldsw = (unsigned)wid * 1024u;
    const int aoff = lds_byte(wr * 64 + fr, fq * 8), boff = lds_byte(wc * 32 + fr, fq * 8);
#define PG8_SA(b, h) (((b) * 2 + (h)) * HTB)
#define PG8_SB(b, h) ((4 + (b) * 2 + (h)) * HTB)
#define PG8_STAGE(bufoff, gbase, voff) do { _Pragma("unroll") for (int _i = 0; _i < 2; ++_i) \
        __builtin_amdgcn_global_load_lds((const unsigned*)((const char*)(gbase) + (voff)[_i]), (PG8_LAS unsigned*)(lds + (bufoff) + ldsw + _i * 8192), 16, 0, 0); } while (0)
#define PG8_LDA(dst, b, h) do { _Pragma("unroll") for (int m = 0; m < 4; ++m) _Pragma("unroll") for (int k = 0; k < 2; ++k) dst[m][k] = *(const PG8_LAS bf16x8*)(lds + PG8_SA(b, h) + aoff + m * 2048 + k * 1024); } while (0)
#define PG8_LDB(dst, b, h) do { _Pragma("unroll") for (int n = 0; n < 2; ++n) _Pragma("unroll") for (int k = 0; k < 2; ++k) dst[n][k] = *(const PG8_LAS bf16x8*)(lds + PG8_SB(b, h) + boff + n * 2048 + k * 1024); } while (0)
#define PG8_MMA(ai, bj, At, Bt) do { __builtin_amdgcn_s_setprio(1); _Pragma("unroll") for (int m = 0; m < 4; ++m) _Pragma("unroll") for (int n = 0; n < 2; ++n) _Pragma("unroll") for (int k = 0; k < 2; ++k) \
        acc[ai][bj][m][n] = __builtin_amdgcn_mfma_f32_16x16x32_bf16(Bt[n][k], At[m][k], acc[ai][bj][m][n], 0, 0, 0); __builtin_amdgcn_s_setprio(0); } while (0)
#define PG8_WAIT_V(n) asm volatile("s_waitcnt vmcnt(" #n ")" ::: "memory")
#define PG8_WAIT_L(n) asm volatile("s_waitcnt lgkmcnt(" #n ")" ::: "memory")
#define PG8_BAR __builtin_amdgcn_s_barrier()
#define PG8_SCHED __builtin_amdgcn_sched_barrier(0)
    Unit cur, nxt; int ui = 0;
    if (!S.next(0, cur)) return;
    f32x4 acc[2][2][4][2];
#pragma unroll
    for (int a = 0; a < 2; ++a)
#pragma unroll
        for (int b = 0; b < 2; ++b)
#pragma unroll
            for (int m = 0; m < 4; ++m)
#pragma unroll
                for (int n = 0; n < 2; ++n) acc[a][b][m][n] = (f32x4){0.f, 0.f, 0.f, 0.f};
    bf16x8 At[4][2], B0[2][2], B1[2][2];
    const char* cA = (const char*)g.A + (size_t)cur.pm * tstep; const char* cB = (const char*)g.Bt + (size_t)cur.pn * tstep;
    S.a_ready(cur);
    if constexpr (SP2) {
        PG8_STAGE(PG8_SB(0, 0), cB, voffB); PG8_STAGE(PG8_SB(0, 1), cB + hstep, voffB); PG8_STAGE(PG8_SA(0, 0), cA, voffA); PG8_STAGE(PG8_SA(0, 1), cA + hstep, voffA);
        if (wr == 1) PG8_BAR;
        PG8_WAIT_V(2); PG8_BAR;
        PG8_STAGE(PG8_SB(1, 0), cB + kstep, voffB); PG8_STAGE(PG8_SA(1, 0), cA + kstep, voffA); PG8_STAGE(PG8_SB(1, 1), cB + hstep + kstep, voffB);
        PG8_WAIT_V(6); PG8_BAR;
    } else {
        PG8_STAGE(PG8_SB(0, 0), cB, voffB); PG8_STAGE(PG8_SA(0, 0), cA, voffA); PG8_STAGE(PG8_SB(0, 1), cB + hstep, voffB); PG8_STAGE(PG8_SA(0, 1), cA + hstep, voffA);
        if (wr == 1) PG8_BAR;
        PG8_WAIT_V(4); PG8_BAR;
        PG8_STAGE(PG8_SB(1, 0), cB + kstep, voffB); PG8_STAGE(PG8_SA(1, 0), cA + kstep, voffA); PG8_STAGE(PG8_SB(1, 1), cB + hstep + kstep, voffB);
        PG8_WAIT_V(6); PG8_BAR;
    }
    for (;;) {
        const bool has_next = S.next(ui + 1, nxt);
        const char* nA = has_next ? (const char*)g.A + (size_t)nxt.pm * tstep : cA; const char* nB = has_next ? (const char*)g.Bt + (size_t)nxt.pn * tstep : cB;
        for (int t = 0; t < nt; t += 2) {
            const bool last = (t == nt - 2);
            const char* a1 = cA + (size_t)(t + 1) * kstep;
            const char* a2 = last ? nA : cA + (size_t)(t + 2) * kstep; const char* b2 = last ? nB : cB + (size_t)(t + 2) * kstep;
            const char* a3 = a2 + kstep; const char* b3 = b2 + kstep;
            if (last && has_next) S.a_ready(nxt);
            if constexpr (SP2) {
            PG8_LDB(B0, 0, 0); PG8_LDB(B1, 0, 1); PG8_SCHED; PG8_LDA(At, 0, 0); PG8_STAGE(PG8_SA(1, 1), a1 + hstep, voffA);
            PG8_WAIT_V(8); PG8_WAIT_L(0); PG8_BAR; PG8_MMA(0, 0, At, B0); PG8_MMA(0, 1, At, B1); PG8_BAR; PG8_SCHED;
            PG8_LDA(At, 0, 1); PG8_STAGE(PG8_SB(0, 0), b2, voffB); PG8_STAGE(PG8_SB(0, 1), b2 + hstep, voffB); PG8_STAGE(PG8_SA(0, 0), a2, voffA);
            PG8_WAIT_V(8); PG8_WAIT_L(0); PG8_BAR; PG8_MMA(1, 0, At, B0); PG8_MMA(1, 1, At, B1); PG8_BAR; PG8_SCHED;
            PG8_LDB(B0, 1, 0); PG8_LDB(B1, 1, 1); PG8_SCHED; PG8_LDA(At, 1, 0); PG8_STAGE(PG8_SA(0, 1), a2 + hstep, voffA);
            PG8_WAIT_V(8); PG8_WAIT_L(0); PG8_BAR; PG8_MMA(0, 0, At, B0); PG8_MMA(0, 1, At, B1); PG8_BAR; PG8_SCHED;
            PG8_LDA(At, 1, 1); PG8_STAGE(PG8_SB(1, 0), b3, voffB); PG8_STAGE(PG8_SB(1, 1), b3 + hstep, voffB); PG8_STAGE(PG8_SA(1, 0), a3, voffA);
            PG8_WAIT_V(8); PG8_WAIT_L(0); PG8_BAR; PG8_MMA(1, 0, At, B0); PG8_MMA(1, 1, At, B1); PG8_BAR; PG8_SCHED;
            } else {
            PG8_LDB(B0, 0, 0); PG8_SCHED; PG8_LDA(At, 0, 0); PG8_STAGE(PG8_SA(1, 1), a1 + hstep, voffA);
            PG8_WAIT_L(8); PG8_BAR; PG8_WAIT_L(0); PG8_MMA(0, 0, At, B0); PG8_BAR; PG8_SCHED;
            PG8_LDB(B1, 0, 1); PG8_STAGE(PG8_SB(0, 0), b2, voffB);
            PG8_BAR; PG8_WAIT_L(0); PG8_MMA(0, 1, At, B1); PG8_BAR;
            PG8_LDA(At, 0, 1); PG8_STAGE(PG8_SA(0, 0), a2, voffA);
            PG8_BAR; PG8_WAIT_L(0); PG8_MMA(1, 0, At, B0); PG8_BAR; PG8_SCHED;
            PG8_STAGE(PG8_SB(0, 1), b2 + hstep, voffB);
            PG8_WAIT_V(6); PG8_BAR; PG8_MMA(1, 1, At, B1); PG8_BAR;
            PG8_LDB(B0, 1, 0); PG8_SCHED; PG8_LDA(At, 1, 0); PG8_STAGE(PG8_SA(0, 1), a2 + hstep, voffA);
            PG8_WAIT_L(8); PG8_BAR; PG8_WAIT_L(0); PG8_MMA(0, 0, At, B0); PG8_BAR; PG8_SCHED;
            PG8_LDB(B1, 1, 1); PG8_STAGE(PG8_SB(1, 0), b3, voffB);
            PG8_BAR; PG8_WAIT_L(0); PG8_MMA(0, 1, At, B1); PG8_BAR;
            PG8_LDA(At, 1, 1); PG8_STAGE(PG8_SA(1, 0), a3, voffA);
            PG8_BAR; PG8_WAIT_L(0); PG8_MMA(1, 0, At, B0); PG8_BAR; PG8_SCHED;
            PG8_STAGE(PG8_SB(1, 1), b3 + hstep, voffB);
            PG8_WAIT_V(6); PG8_BAR; PG8_MMA(1, 1, At, B1); PG8_BAR;
            }
        }
        if constexpr (ALIGN_EPI) { if (wr == 0) PG8_BAR; }
        if constexpr (!Epi::AFTER_DRAIN) { E(acc, cur, wr, wc, fr, fq); S.done(cur); }
        if (!has_next) break;
#pragma unroll
        for (int a = 0; a < 2; ++a)
#pragma unroll
            for (int b = 0; b < 2; ++b)
#pragma unroll
                for (int m = 0; m < 4; ++m)
#pragma unroll
                    for (int n = 0; n < 2; ++n) acc[a][b][m][n] = (f32x4){0.f, 0.f, 0.f, 0.f};
        cur = nxt; cA = nA; cB = nB; ++ui;
        if constexpr (ALIGN_EPI) { if (wr == 1) PG8_BAR; }
    }
    PG8_WAIT_V(0);
    if constexpr (!ALIGN_EPI) { if (wr == 0) PG8_BAR; }
    PG8_BAR;
    if constexpr (Epi::AFTER_DRAIN) { E.fused(acc, cur, wr, wc, fr, fq, lds, wid, lane); S.done(cur); }
#undef PG8_SA
#undef PG8_SB
#undef PG8_STAGE
#undef PG8_LDA
#undef PG8_LDB
#undef PG8_MMA
#undef PG8_WAIT_V
#undef PG8_WAIT_L
#undef PG8_BAR
#undef PG8_SCHED
}
}

#ifndef PG8_SP2
#define PG8_SP2 true
#endif
#ifndef PG8_ALIGN
#define PG8_ALIGN true
#endif
#include <hip/hip_bf16.h>
#include <cmath>
namespace attn_body {
using bf16=__hip_bfloat16;
using bf16x8=__attribute__((ext_vector_type(8)))short;
using s16x4=__attribute__((ext_vector_type(4)))short;
using f32x16=__attribute__((ext_vector_type(16)))float;
using f32x4=__attribute__((ext_vector_type(4)))float;
using u32x4=__attribute__((ext_vector_type(4)))unsigned;
using u32x2=__attribute__((ext_vector_type(2)))unsigned;
constexpr int BATCH=16,NHEAD=8,SEQ=2048,D=64,DM=NHEAD*D;
constexpr int OPITCH=1024;
constexpr int NW=8,QBLK=32,QB=QBLK*NW,KVBLK=64,NQB=SEQ/QB;
constexpr int ATTN_PITCH=DM, ATTN_UNIT_ROWS=QB;
constexpr float RMS_EPS=1e-6f;
__device__ __forceinline__ int crow(int r,int hi){return (r&3)+8*(r>>2)+4*hi;}
#define SBAR() __builtin_amdgcn_sched_barrier(0)
__device__ __forceinline__ void cmask(f32x16&p0,f32x16&p1,int jb,int qrel,int hi){
  const float NEG=-INFINITY; int kb=64*jb+4*hi;
  #pragma unroll
  for(int r=0;r<16;++r){int kv=kb+(r&3)+8*(r>>2); if(kv>qrel)p0[r]=NEG; if(kv+32>qrel)p1[r]=NEG;}
}

constexpr int NSLOT=3, SLOTB=8192;
constexpr int LDS_K=0, LDS_V=NSLOT*SLOTB, LDS_WS=2*NSLOT*SLOTB, LDS_OST=LDS_WS+NW*64*4, LDS_XK=LDS_OST+NW*4096+2048, LDS_ONES=LDS_XK+SEQ*8, LDS_BYTES=LDS_ONES+512;
constexpr float LOG2E=1.4426950408889634f;
constexpr float C2=0.125f*LOG2E;
__device__ __forceinline__ void glds16(const void*gsrc,unsigned lds_dst){unsigned keep;
  asm volatile("s_mov_b32 %0, m0\n\ts_mov_b32 m0, %2\n\ts_nop 0\n\tglobal_load_lds_dwordx4 %1, off\n\ts_mov_b32 m0, %0":"=&s"(keep):"v"(gsrc),"s"(lds_dst):"memory");}
__device__ __forceinline__ float max3f(float a,float b,float c){float r;asm("v_max3_f32 %0, %1, %2, %3":"=v"(r):"v"(a),"v"(b),"v"(c));return r;}
__device__ __forceinline__ float max2f(float a,float b){float r;asm("v_max_f32_e32 %0, %1, %2":"=v"(r):"v"(a),"v"(b));return r;}
__device__ __forceinline__ float fadd_s(float a,float b){float r;asm("v_add_f32_e32 %0, %1, %2":"=v"(r):"v"(a),"v"(b));return r;}
__device__ __forceinline__ float fsub_s(float a,float b){float r;asm("v_sub_f32_e32 %0, %1, %2":"=v"(r):"v"(a),"v"(b));return r;}
typedef float f32x2_t __attribute__((ext_vector_type(2))); typedef __bf16 bf16x2_t __attribute__((ext_vector_type(2)));
__device__ __forceinline__ unsigned cvtpk_s(float lo,float hi){f32x2_t v={lo,hi};bf16x2_t b=__builtin_convertvector(v,bf16x2_t);return __builtin_bit_cast(unsigned,b);}
#define WAIT_BAR(N) asm volatile("s_waitcnt vmcnt(" #N ") lgkmcnt(0)\n\ts_barrier":::"memory")
__device__ __forceinline__ unsigned bf16_rn(float f){unsigned u=__float_as_uint(f);return (u+0x7fffu+((u>>16)&1u))>>16;}
__device__ __forceinline__ void split3(float x,unsigned&a,unsigned&b,unsigned&c){a=bf16_rn(x);float r=x-__uint_as_float(a<<16);b=bf16_rn(r);r-=__uint_as_float(b<<16);c=bf16_rn(r);}
__device__ __forceinline__ float beta_at(const float*__restrict__ LPRE,const float*__restrict__ CHT,int b,int h,int pos){
  float carry=0.f; const int ck=pos>>7; for(int j=0;j<ck;++j)carry+=CHT[(b*(SEQ/128)+j)*NHEAD+h];
  return -(LPRE[((long)b*SEQ+pos)*NHEAD+h]+carry)*LOG2E; }
typedef __attribute__((address_space(3))) const char* lds_cptr;
typedef short v4i16_t __attribute__((ext_vector_type(4)));
#define KXF(v) __builtin_bit_cast(bf16x8,(u32x4){(v)[0],(v)[1],0u,0u})
__device__ __forceinline__ u32x2 kxload(lds_cptr p){ return *(const __attribute__((address_space(3))) u32x2*)p; }

__device__ __forceinline__ void qkt(f32x16&p0,f32x16&p1,const char*Kslot,const bf16x8*qr,int r32,int hi,lds_cptr kxp){
  const char*kb=Kslot+hi*1024+r32*16;
  { const u32x2 x0=kxload(kxp),x1=kxload(kxp+256);
    p0=__builtin_amdgcn_mfma_f32_32x32x16_bf16(KXF(x0),qr[4],f32x16{},0,0,0);p1=__builtin_amdgcn_mfma_f32_32x32x16_bf16(KXF(x1),qr[4],f32x16{},0,0,0); }
  #pragma unroll
  for(int d0=0;d0<4;++d0){
    const bf16x8 b0=*reinterpret_cast<const bf16x8*>(kb+d0*2048);
    const bf16x8 b1=*reinterpret_cast<const bf16x8*>(kb+d0*2048+512);
    p0=__builtin_amdgcn_mfma_f32_32x32x16_bf16(b0,qr[d0],p0,0,0,0);p1=__builtin_amdgcn_mfma_f32_32x32x16_bf16(b1,qr[d0],p1,0,0,0);}
}
__device__ __forceinline__ void kload8(bf16x8*kf,lds_cptr kp){
  kf[0]=*(const __attribute__((address_space(3))) bf16x8*)(kp);      kf[1]=*(const __attribute__((address_space(3))) bf16x8*)(kp+512);
  kf[2]=*(const __attribute__((address_space(3))) bf16x8*)(kp+2048); kf[3]=*(const __attribute__((address_space(3))) bf16x8*)(kp+2560);
  kf[4]=*(const __attribute__((address_space(3))) bf16x8*)(kp+4096); kf[5]=*(const __attribute__((address_space(3))) bf16x8*)(kp+4608);
  kf[6]=*(const __attribute__((address_space(3))) bf16x8*)(kp+6144); kf[7]=*(const __attribute__((address_space(3))) bf16x8*)(kp+6656);
}
__device__ __forceinline__ void kload2(bf16x8*kf,lds_cptr kp,int j){ kf[2*j]=*(const __attribute__((address_space(3))) bf16x8*)(kp+j*2048); kf[2*j+1]=*(const __attribute__((address_space(3))) bf16x8*)(kp+j*2048+512); }
__device__ __forceinline__ s16x4 vtr(lds_cptr p){ return __builtin_bit_cast(s16x4,__builtin_amdgcn_ds_read_tr16_b64_v4i16((__attribute__((address_space(3))) v4i16_t*)p)); }
__device__ __forceinline__ float rowmax(const f32x16&p0,const f32x16&p1){
  float a=max3f(p0[0],p0[1],p1[0]),b=max3f(p0[2],p0[3],p1[1]);a=max3f(a,p1[2],p1[3]);
  #pragma unroll
  for(int r=4;r<16;r+=4){a=max3f(a,p0[r],p0[r+1]);b=max3f(b,p0[r+2],p0[r+3]);a=max3f(a,p1[r],p1[r+1]);b=max3f(b,p1[r+2],p1[r+3]);}
  const float m=max2f(a,b);
  auto rr=__builtin_amdgcn_permlane32_swap(__float_as_uint(m),__float_as_uint(m),false,false);
  return max2f(__uint_as_float(rr[0]),__uint_as_float(rr[1]));
}
__device__ __forceinline__ void pv(f32x16*o,int vb,bf16x8 pa0,bf16x8 pa1,bf16x8 pa2,bf16x8 pa3){
  #pragma unroll
  for(int d0=0;d0<2;++d0){s16x4 lo[4],hi[4];
    #pragma unroll
    for(int ks=0;ks<4;++ks){
      asm volatile("ds_read_b64_tr_b16 %0,%1 offset:%c2":"=&v"(lo[ks]):"v"(vb),"i"(d0*4096+ks*1024):"memory");
      asm volatile("ds_read_b64_tr_b16 %0,%1 offset:%c2":"=&v"(hi[ks]):"v"(vb),"i"(d0*4096+ks*1024+512):"memory");}
    asm volatile("s_waitcnt lgkmcnt(0)":::"memory");SBAR();
    #define PK(k) (bf16x8){lo[k][0],lo[k][1],lo[k][2],lo[k][3],hi[k][0],hi[k][1],hi[k][2],hi[k][3]}
    o[d0]=__builtin_amdgcn_mfma_f32_32x32x16_bf16(pa0,PK(0),o[d0],0,0,0);
    o[d0]=__builtin_amdgcn_mfma_f32_32x32x16_bf16(pa1,PK(1),o[d0],0,0,0);
    o[d0]=__builtin_amdgcn_mfma_f32_32x32x16_bf16(pa2,PK(2),o[d0],0,0,0);
    o[d0]=__builtin_amdgcn_mfma_f32_32x32x16_bf16(pa3,PK(3),o[d0],0,0,0);
    #undef PK
  }
}

#ifndef ATTN_STORE16
#define ATTN_STORE16(p,v) (*(u32x4*)(p)=(v))
#endif
struct AttnTensors { const bf16* Q; const bf16* K; const bf16* V; bf16* O; const float* LPRE; const float* CHT; const float* GO; };
template<int THRL> __device__ __forceinline__ void attn_unit(int b,int h,int qb,const AttnTensors&T,char*shm){
  const bf16*Q=T.Q; const bf16*__restrict__ K=T.K; const bf16*__restrict__ V=T.V; bf16*O=T.O;
  const int tid=threadIdx.x,lane=tid&63,r32=lane&31,hi=lane>>5; const int wid=__builtin_amdgcn_readfirstlane(tid>>6);
  const long rowbase=(long)b*SEQ; const int q0=qb*QB;
  const bf16*Qw=Q+(rowbase+q0+wid*QBLK)*DM+h*D;
  const bf16*Kh=K+rowbase*DM+h*D,*Vh=V+rowbase*DM+h*D;
  const unsigned lds0=(unsigned)(uintptr_t)shm;
  float*wsf=(float*)(shm+LDS_WS)+wid*64;
  const bf16*ksrc=Kh+(long)lane*DM+wid*8;
  const bf16*vsrc=Vh+(long)(16*(wid&3)+(lane>>2))*DM+(wid>>2)*32+(lane&3)*8;
  const unsigned kdst=lds0+LDS_K+wid*1024, vdst=lds0+LDS_V+wid*1024;
  #define DMA_K(t,slot) glds16(ksrc+(long)(t)*KVBLK*DM,(unsigned)__builtin_amdgcn_readfirstlane(kdst+(slot)))
  #define DMA_V(t,slot) glds16(vsrc+(long)(t)*KVBLK*DM,(unsigned)__builtin_amdgcn_readfirstlane(vdst+(slot)))
  const int vb0=(int)(lds0+LDS_V)+((lane>>4)&1)*32+(lane&3)*8+(4*hi+((lane&15)>>2))*64;
  const char*Kbase=shm+LDS_K; bf16x8 kf[8];
  const lds_cptr shm3=(lds_cptr)shm; const lds_cptr kp0=shm3+LDS_K+hi*1024+r32*16; const lds_cptr vp0=shm3+LDS_V+((lane>>4)&1)*32+(lane&3)*8+(4*hi+((lane&15)>>2))*64;
  const int NT=(q0+QB)/KVBLK;
  DMA_K(0,0);DMA_V(0,0);DMA_K(1,SLOTB);
  { int tidv=tid; asm volatile("":"+v"(tidv));
    const int s0=4*tidv;
    if(s0<q0+QB){ float carry=0.f; const int ck=s0>>7; for(int j=0;j<ck;++j)carry+=T.CHT[(b*(SEQ/128)+j)*NHEAD+h];
      #pragma unroll
      for(int i=0;i<4;++i){ const float beta=-(T.LPRE[(rowbase+s0+i)*NHEAD+h]+carry)*LOG2E; unsigned a,bb,c; split3(beta,a,bb,c);
        *(__attribute__((address_space(3))) u32x2*)(shm3+LDS_XK+(s0+i)*8)=(u32x2){a|(bb<<16),c|0x3F800000u}; } }
    if(tidv<64)*(__attribute__((address_space(3))) u32x2*)(shm3+LDS_ONES+tidv*8)=(u32x2){0x3F803F80u,0x3F803F80u}; }
  bf16x8 qr[5]; u32x4 q4;
  #pragma unroll
  for(int d0=0;d0<4;++d0)qr[d0]=*reinterpret_cast<const bf16x8*>(&Qw[(long)r32*DM+d0*16+hi*8]);
  { const float bq=beta_at(T.LPRE,T.CHT,b,h,q0+wid*QBLK+r32); unsigned a,bb,c; split3(-bq,a,bb,c);
    q4=hi?(u32x4){a|(bb<<16),c,0u,0u}:(u32x4){0x3F803F80u,0x00003F80u,0u,0u}; }
  const lds_cptr kxb=hi?(shm3+LDS_ONES+r32*8):(shm3+LDS_XK+r32*8); const int kxs=hi?0:512;
  float mhat=0.f,l_reg=0.f;f32x16 o[2];o[0]=f32x16{};o[1]=f32x16{};
  #define SETM() do{ unsigned a_=bf16_rn(-mhat); const float lo_=-mhat-__uint_as_float(a_<<16); const unsigned b_=bf16_rn(lo_); q4[1]=(q4[1]&0xffffu)|((hi?b_:a_)<<16); qr[4]=__builtin_bit_cast(bf16x8,q4); }while(0)
  SETM();
  const int qrel=wid*QBLK+r32;
  #define CMASK(P0,P1,t) do{int jb_=(t)-(NT-4); if(jb_>=0)cmask(P0,P1,jb_,qrel,hi);}while(0)
  bool resc=false;
  #define START(P0,P1) do{ const float rm=rowmax(P0,P1); resc=false; \
    { const float dl=__builtin_ceilf(rm); mhat=fadd_s(mhat,dl); \
      _Pragma("unroll") for(int r=0;r<16;++r){P0[r]=fsub_s(P0[r],dl);P1[r]=fsub_s(P1[r],dl);} \
      SETM(); } \
    _Pragma("unroll") for(int r=0;r<16;++r)P0[r]=__builtin_amdgcn_exp2f(P0[r]); }while(0)
  #define RESC() do{ if(resc){ asm volatile("s_waitcnt lgkmcnt(0)":::"memory"); \
      _Pragma("unroll") for(int d_=0;d_<2;++d_) _Pragma("unroll") for(int r=0;r<16;++r)o[d_][r]*=wsf[crow(r,hi)]; } }while(0)
  f32x16 pA0,pA1,pB0,pB1;
  int sl_prev=0,sl_cur=0,sl_next=SLOTB;
  #define ROT() do{sl_prev=sl_cur;sl_cur=sl_next;sl_next=(sl_next==(NSLOT-1)*SLOTB)?0:sl_next+SLOTB;}while(0)
  DMA_K(2,2*SLOTB);
  WAIT_BAR(3);
  qkt(pA0,pA1,Kbase,qr,r32,hi,kxb);asm volatile("s_nop 15\n\ts_nop 7":"+v"(pA0),"+v"(pA1));CMASK(pA0,pA1,0);
  START(pA0,pA1);
  _Pragma("unroll") for(int r=0;r<16;++r)pA1[r]=__builtin_amdgcn_exp2f(pA1[r]);
  WAIT_BAR(0);
  DMA_K(3,0);DMA_V(1,SLOTB);
  ROT();
  kload8(kf,kp0+sl_cur);
  WAIT_BAR(2);
  s16x4 vlo[8],vhi[8]; u32x4 pw0,pw1,pw2,pw3;
  #define PKW(P,B) cvtpk_s(P[B],P[B+1])
  #define PAF(k) __builtin_bit_cast(bf16x8,pw##k)
  #define VFR(i) (bf16x8){vlo[i][0],vlo[i][1],vlo[i][2],vlo[i][3],vhi[i][0],vhi[i][1],vhi[i][2],vhi[i][3]}
  #define PIN(x) asm volatile("":"+v"(x))
  #define MX3(a,b,c) __builtin_fmaxf(__builtin_fmaxf((a),(b)),(c))
  #define GAPA(MF,A0,A1,A2,A3,W0,W1,PW) do{ MF; sacc+=A0; sacc+=A1; sacc+=A2; sacc+=A3; PIN(sacc); W0; W1; PIN(PW); SBAR(); }while(0)
  #define EX(v) __builtin_amdgcn_exp2f(v)
  #define GAPB(MF,X,B) do{ MF; X[B]=EX(X[B]); X[B+1]=EX(X[B+1]); X[B+2]=EX(X[B+2]); X[B+3]=EX(X[B+3]); PIN(X); SBAR(); }while(0)
  #define VRD(i) do{ vlo[i]=vtr(vp_+(((i)>>2)*4096+((i)&3)*1024)); vhi[i]=vtr(vp_+(((i)>>2)*4096+((i)&3)*1024+512)); }while(0)
  #define KRD(G,j) do{ if(G){ kload2(kf,kp0+sl_next,j); SBAR(); } }while(0)
  #define STEP(C0,C1,P0,P1,t,GK,GV,GL) do{ SBAR(); \
    const lds_cptr vp_=vp0+sl_prev; const lds_cptr kxp_=kxb+(t)*kxs; \
    const u32x2 kx0_=kxload(kxp_),kx1_=kxload(kxp_+256); SBAR(); \
    VRD(0); SBAR(); float sacc=(P0[0]+P0[1]); \
    C0=__builtin_amdgcn_mfma_f32_32x32x16_bf16(KXF(kx0_),qr[4],f32x16{},0,0,0); C1=__builtin_amdgcn_mfma_f32_32x32x16_bf16(KXF(kx1_),qr[4],f32x16{},0,0,0); SBAR(); \
    GAPA(C0=__builtin_amdgcn_mfma_f32_32x32x16_bf16(kf[0],qr[0],C0,0,0,0), P0[2],P0[3],P0[4],P0[5],     pw0[0]=PKW(P0,0), pw0[1]=PKW(P0,2), pw0); \
    VRD(4); SBAR(); GAPA(C1=__builtin_amdgcn_mfma_f32_32x32x16_bf16(kf[1],qr[0],C1,0,0,0), P0[6],P0[7],P0[8],P0[9],     pw0[2]=PKW(P0,4), pw0[3]=PKW(P0,6), pw0); \
    VRD(1); SBAR(); GAPA(C0=__builtin_amdgcn_mfma_f32_32x32x16_bf16(kf[2],qr[1],C0,0,0,0),   P0[10],P0[11],P0[12],P0[13], pw1[0]=PKW(P0,8), pw1[1]=PKW(P0,10), pw1); \
    VRD(5); SBAR(); GAPA(C1=__builtin_amdgcn_mfma_f32_32x32x16_bf16(kf[3],qr[1],C1,0,0,0),   P0[14],P0[15],P1[0],P1[1],   pw1[2]=PKW(P0,12),pw1[3]=PKW(P0,14), pw1); \
    VRD(2); SBAR(); GAPA(C0=__builtin_amdgcn_mfma_f32_32x32x16_bf16(kf[4],qr[2],C0,0,0,0),   P1[2],P1[3],P1[4],P1[5],     pw2[0]=PKW(P1,0), pw2[1]=PKW(P1,2), pw2); \
    VRD(6); SBAR(); GAPA(C1=__builtin_amdgcn_mfma_f32_32x32x16_bf16(kf[5],qr[2],C1,0,0,0),   P1[6],P1[7],P1[8],P1[9],     pw2[2]=PKW(P1,4), pw2[3]=PKW(P1,6), pw2); \
    VRD(3); SBAR(); GAPA(C0=__builtin_amdgcn_mfma_f32_32x32x16_bf16(kf[6],qr[3],C0,0,0,0),   P1[10],P1[11],P1[12],P1[13], pw3[0]=PKW(P1,8), pw3[1]=PKW(P1,10), pw3); \
    VRD(7); SBAR(); GAPA(C1=__builtin_amdgcn_mfma_f32_32x32x16_bf16(kf[7],qr[3],C1,0,0,0),   P1[14],P1[15],0.f,0.f,       pw3[2]=PKW(P1,12),pw3[3]=PKW(P1,14), pw3); \
    l_reg+=sacc; \
    if(GK){DMA_K((t)+3,sl_cur);} if(GV){DMA_V((t)+1,sl_next);} \
    CMASK(C0,C1,t); \
    { float a=MX3(C0[0],C0[1],C1[0]),b=MX3(C0[2],C0[3],C1[1]); a=MX3(a,C1[2],C1[3]); \
      _Pragma("unroll") for(int r=4;r<16;r+=4){a=MX3(a,C0[r],C0[r+1]);b=MX3(b,C0[r+2],C0[r+3]);a=MX3(a,C1[r],C1[r+1]);b=MX3(b,C1[r+2],C1[r+3]);} \
      float rm=__builtin_fmaxf(a,b); { auto rr=__builtin_amdgcn_permlane32_swap(__float_as_uint(rm),__float_as_uint(rm),false,false); rm=__builtin_fmaxf(__uint_as_float(rr[0]),__uint_as_float(rr[1])); } \
      resc=false; \
      if(__builtin_expect(__any(rm>(float)THRL),0)){ const float dl=__builtin_ceilf(__builtin_fmaxf(rm,0.f)); mhat+=dl; \
        _Pragma("unroll") for(int r=0;r<16;++r){C0[r]-=dl;C1[r]-=dl;} \
        SETM(); \
        const float f=__builtin_amdgcn_exp2f(-dl); l_reg*=f; if(hi==0)wsf[r32]=f; resc=true; } } \
    SBAR(); \
    GAPB(o[0]=__builtin_amdgcn_mfma_f32_32x32x16_bf16(PAF(0),VFR(0),o[0],0,0,0), C0,0); \
    GAPB(o[1]=__builtin_amdgcn_mfma_f32_32x32x16_bf16(PAF(0),VFR(4),o[1],0,0,0), C0,4); \
    KRD(GL,0); GAPB(o[0]=__builtin_amdgcn_mfma_f32_32x32x16_bf16(PAF(1),VFR(1),o[0],0,0,0), C0,8); \
    KRD(GL,1); GAPB(o[1]=__builtin_amdgcn_mfma_f32_32x32x16_bf16(PAF(1),VFR(5),o[1],0,0,0), C0,12); \
    KRD(GL,2); GAPB(o[0]=__builtin_amdgcn_mfma_f32_32x32x16_bf16(PAF(2),VFR(2),o[0],0,0,0), C1,0); \
    KRD(GL,3); GAPB(o[1]=__builtin_amdgcn_mfma_f32_32x32x16_bf16(PAF(2),VFR(6),o[1],0,0,0), C1,4); \
    GAPB(o[0]=__builtin_amdgcn_mfma_f32_32x32x16_bf16(PAF(3),VFR(3),o[0],0,0,0), C1,8); \
    GAPB(o[1]=__builtin_amdgcn_mfma_f32_32x32x16_bf16(PAF(3),VFR(7),o[1],0,0,0), C1,12); \
    }while(0)
  int t=1;
  #undef CMASK
  #define CMASK(P0,P1,t) do{}while(0)
  for(;t+5<NT;t+=2){
    STEP(pB0,pB1,pA0,pA1,t,true,true,true);     WAIT_BAR(2); RESC(); ROT();
    STEP(pA0,pA1,pB0,pB1,t+1,true,true,true);   WAIT_BAR(2); RESC(); ROT();
  }
  #undef CMASK
  #define CMASK(P0,P1,t) do{int jb_=(t)-(NT-4); if(jb_>=0)cmask(P0,P1,jb_,qrel,hi);}while(0)
  #define ENDW(tt) do{ if((tt)+3<NT){WAIT_BAR(2);} else if((tt)+2<NT){WAIT_BAR(1);} else {WAIT_BAR(0);} }while(0)
  for(;t+1<NT;t+=2){
    STEP(pB0,pB1,pA0,pA1,t,(t+3<NT),(t+1<NT),(t+1<NT));       ENDW(t);   RESC(); ROT();
    STEP(pA0,pA1,pB0,pB1,t+1,(t+4<NT),(t+2<NT),(t+2<NT));     ENDW(t+1); RESC(); ROT();
  }
  STEP(pB0,pB1,pA0,pA1,NT-1,false,false,false); RESC();
  { float sacc=pB0[0]+pB0[1]; _Pragma("unroll") for(int r=2;r<16;++r)sacc+=pB0[r]; _Pragma("unroll") for(int r=0;r<16;++r)sacc+=pB1[r]; l_reg+=sacc;
    pw0=(u32x4){PKW(pB0,0),PKW(pB0,2),PKW(pB0,4),PKW(pB0,6)};pw1=(u32x4){PKW(pB0,8),PKW(pB0,10),PKW(pB0,12),PKW(pB0,14)};pw2=(u32x4){PKW(pB1,0),PKW(pB1,2),PKW(pB1,4),PKW(pB1,6)};pw3=(u32x4){PKW(pB1,8),PKW(pB1,10),PKW(pB1,12),PKW(pB1,14)};
    SBAR(); pv(o,vb0+sl_cur,PAF(0),PAF(1),PAF(2),PAF(3)); }
  #undef PKW
  #undef PAF
  #undef VFR
  #undef PIN
  #undef MX3
  #undef GAPA
  #undef GAPB
  #undef EX
  #undef VRD
  #undef KRD
  #undef STEP
  #undef ENDW
  {auto rr=__builtin_amdgcn_permlane32_swap(__float_as_uint(l_reg),__float_as_uint(l_reg),false,false);l_reg=__uint_as_float(rr[0])+__uint_as_float(rr[1]);}
  if(hi==0)wsf[32+r32]=l_reg;asm volatile("s_waitcnt lgkmcnt(0)":::"memory");
  float rli[16];
  #pragma unroll
  for(int r=0;r<16;++r)rli[r]=__builtin_amdgcn_rcpf(wsf[32+crow(r,hi)]);
  bf16*Ow=O+(rowbase+q0+wid*QBLK)*OPITCH+h*D;
  { float*stg=(float*)(shm+LDS_OST)+wid*1024;
    int lane_e=lane; asm volatile("":"+v"(lane_e));
    const int srow=lane_e>>2,sc16=(lane_e&3)*16;
    f32x4 gq[4];
    #pragma unroll
    for(int j=0;j<4;++j)gq[j]=*(const f32x4*)(T.GO+h*D+sc16+4*j);
    #pragma unroll
    for(int p=0;p<2;++p){
      #pragma unroll
      for(int rr=0;rr<8;++rr){ const int r=8*p+rr, orow=(rr&3)+8*(rr>>2)+4*hi;
        #pragma unroll
        for(int d0=0;d0<2;++d0)stg[orow*64+d0*32+r32]=o[d0][r]*rli[r]; }
      asm volatile("s_waitcnt lgkmcnt(0)":::"memory");
      f32x4 v[4]; float ss=0.f;
      #pragma unroll
      for(int j=0;j<4;++j){ v[j]=*(const f32x4*)(stg+srow*64+sc16+4*j); ss+=(v[j][0]*v[j][0]+v[j][1]*v[j][1])+(v[j][2]*v[j][2]+v[j][3]*v[j][3]); }
      asm volatile("s_waitcnt lgkmcnt(0)":::"memory");
      ss+=__shfl_xor(ss,1); ss+=__shfl_xor(ss,2);
      const float rs=1.0f/sqrtf(ss*(1.0f/64.0f)+RMS_EPS);
      u32x4 w0,w1;
      #pragma unroll
      for(int j=0;j<4;++j)v[j]=v[j]*rs*gq[j];
      w0[0]=cvtpk_s(v[0][0],v[0][1]);w0[1]=cvtpk_s(v[0][2],v[0][3]);w0[2]=cvtpk_s(v[1][0],v[1][1]);w0[3]=cvtpk_s(v[1][2],v[1][3]);
      w1[0]=cvtpk_s(v[2][0],v[2][1]);w1[1]=cvtpk_s(v[2][2],v[2][3]);w1[2]=cvtpk_s(v[3][0],v[3][1]);w1[3]=cvtpk_s(v[3][2],v[3][3]);
      bf16*op=Ow+(long)(16*p+srow)*OPITCH+sc16; ATTN_STORE16(op,w0); ATTN_STORE16(op+8,w1);
    } }
  asm volatile("s_waitcnt lgkmcnt(0)\n\ts_barrier":::"memory");
  #undef DMA_K
  #undef DMA_V
  #undef CMASK
  #undef START
  #undef RESC
  #undef ROT
  #undef SETM
}
constexpr int ATTN_LDS_BYTES=LDS_BYTES;
struct AttnUnit { int bh; int qb; };
struct StaticOrder {
  int vcu, G;
  __device__ __forceinline__ explicit StaticOrder(int grid,int vcu_):vcu(vcu_),G(grid){}
  __device__ __forceinline__ bool next(int i,AttnUnit&u)const{
    if(G==256){ if(i>=4)return false; const int s=vcu&1; u.bh=vcu>>1; u.qb=(i==0)?7-s:(i==1)?4+s:(i==2)?3-s:s; return true; }
    const int idx=i*G+vcu; if(idx>=BATCH*NHEAD*NQB)return false; u.bh=idx/NQB; u.qb=NQB-1-(idx%NQB); return true; }
};
template<int THRL=8> __device__ __forceinline__ void attn_phase(char*lds,const AttnTensors&T,const StaticOrder&S){
  AttnUnit u;
  for(int i=0;S.next(i,u);++i){ attn_unit<THRL>(u.bh/NHEAD,u.bh%NHEAD,u.qb,T,lds); }
}
#undef SBAR
#undef WAIT_BAR
#undef KXF
}
constexpr int NWAVES = 8;
#ifndef MK_N_LAUNCHES
#define MK_N_LAUNCHES 1
#endif
constexpr int N_LAUNCHES = MK_N_LAUNCHES;
constexpr int PER_PHASE = 8;
constexpr int N_BAR_REGIONS = 1;

constexpr int BATCH = 16, T = 2048, D = 1024, H = 8, HD = 64, AW = 512, CW = 512, FF = 4096, CK = 31;
constexpr int M = BATCH * T;
constexpr int IN_COLS = 3 * AW + 2 * CW + H;
constexpr int NPROJ = 2560;
constexpr float EPS = 1e-6f;

constexpr size_t MiB = 1u << 20;
constexpr size_t WS_CTL = 0, CTL_ZERO_BYTES = 1 * MiB;
constexpr size_t WS_WIN = 2 * MiB, WS_WPW = 7 * MiB, WS_WOUT = 8 * MiB, WS_WUP = 10 * MiB, WS_WDN = 18 * MiB;
constexpr size_t WS_LPRE = 26 * MiB;
constexpr size_t WS_CHT = 27 * MiB;
constexpr size_t WS_SSQ1 = 28 * MiB, WS_SSQ2 = 28 * MiB + 512 * 1024;
constexpr size_t WS_XN = 32 * MiB;
constexpr size_t WS_Q = 96 * MiB, WS_K = 128 * MiB, WS_V = 160 * MiB;
constexpr size_t WS_U = 192 * MiB;
constexpr size_t WS_UC = 224 * MiB;
constexpr size_t WS_CAT = 256 * MiB;
constexpr size_t WS_H = 96 * MiB;
constexpr size_t WS_END = 352 * MiB;
static_assert(WS_CAT + (size_t)M * 1024 * 2 <= WS_END && WS_H + (size_t)M * FF * 2 <= WS_END && WS_XN + (size_t)M * D * 2 <= WS_Q && WS_WDN + (size_t)D * FF * 2 <= WS_LPRE, "d_ws map");
constexpr int CW_TMO = 0, CW_CODE = 1;
constexpr int CW_BAR = 4096;

constexpr int RING_OFF = 0, RING_BYTES = 131072;
constexpr int LDSCTL_OFF = RING_BYTES, MISC_OFF = LDSCTL_OFF + 320;
constexpr int SCR_OFF = RING_BYTES + 1024;
constexpr int LDS_BYTES = 147456;
static_assert(MISC_OFF + 128 <= SCR_OFF && SCR_OFF + 4096 <= LDS_BYTES, "LDS map");
#define GAS __attribute__((address_space(1)))
#define LAS __attribute__((address_space(3)))
typedef unsigned short bf16;
typedef unsigned v4u __attribute__((ext_vector_type(4)));
typedef float f32x4 __attribute__((ext_vector_type(4)));
typedef short bf16x8 __attribute__((ext_vector_type(8)));
typedef GAS unsigned gu32;
typedef GAS unsigned long long gu64;
#define RLX_AGENT __ATOMIC_RELAXED, __HIP_MEMORY_SCOPE_AGENT
#define LDS_WAIT() asm volatile("s_waitcnt lgkmcnt(0)" ::: "memory")
#define VM_WAIT() asm volatile("s_waitcnt vmcnt(0)" ::: "memory")
__device__ __forceinline__ unsigned long long rt() { return __builtin_amdgcn_s_memrealtime(); }
__device__ __forceinline__ unsigned f2bf(float f) { unsigned u = __builtin_bit_cast(unsigned, f); return (u + 0x7fffu + ((u >> 16) & 1u)) >> 16; }
__device__ __forceinline__ unsigned pk2(float lo, float hi) { return f2bf(lo) | (f2bf(hi) << 16); }

#define XB_TMO      128
#define XB_XCNT(j)  (256  + 64 * (j))
#define XB_XSUB(j)  (1280 + 64 * (j))
#define XB_XGEN(j)  (2304 + 64 * (j))
#define XB_TOP      3328
#define XB_TOPGEN   3392
#define XCD_BAR_WORDS 3456
#define XB_SPIN_CAP (1u << 18)

__device__ __forceinline__ unsigned xb_ld(unsigned* p)              { return __hip_atomic_load(p, __ATOMIC_RELAXED, __HIP_MEMORY_SCOPE_AGENT); }
__device__ __forceinline__ unsigned xb_add(unsigned* p, unsigned v) { return __hip_atomic_fetch_add(p, v, __ATOMIC_RELAXED, __HIP_MEMORY_SCOPE_AGENT); }
__device__ __forceinline__ unsigned xb_xcc_id() { return (unsigned)__builtin_amdgcn_s_getreg((3 << 11) | 20) & 0xFu; }
#define XB_SPIN(cond, bar) do { unsigned _sp = 0; while (cond) { __builtin_amdgcn_s_sleep(1); \
    if ((++_sp & 255u) == 0u) { if (xb_ld(&(bar)[XB_TMO])) break; if (_sp > XB_SPIN_CAP) { atomicAdd(&(bar)[XB_TMO], 1u); break; } } } } while (0)

struct XcdBarrier {
    unsigned* bar; unsigned x;
    volatile LAS unsigned* st;
};

__device__ __forceinline__ XcdBarrier xcd_barrier_post(unsigned* bar, volatile LAS unsigned* st) {
    XcdBarrier b; b.bar = bar; b.x = xb_xcc_id(); b.st = st;
    if (threadIdx.x == 0) (void)xb_add(&bar[XB_XCNT(b.x)], 1u);
    return b;
}
__device__ __forceinline__ void xcd_barrier_complete(unsigned* bar, unsigned x, unsigned& nloc, unsigned& nx) {
    const unsigned G = gridDim.x * gridDim.y * gridDim.z;
    unsigned sum, cnt, mine, sp = 0u;
    for (;;) {
        sum = 0u; cnt = 0u; mine = 0u;
#pragma unroll
        for (unsigned j = 0; j < 16; ++j) { const unsigned c = xb_ld(&bar[XB_XCNT(j)]); sum += c; cnt += (c > 0u) ? 1u : 0u; mine = (j == x) ? c : mine; }
        if (sum == G) break;
        __builtin_amdgcn_s_sleep(1);
        if ((++sp & 255u) == 0u) { if (xb_ld(&bar[XB_TMO])) break; if (sp > XB_SPIN_CAP) { atomicAdd(&bar[XB_TMO], 1u); break; } }
    }
    nloc = mine > 0u ? mine : 1u; nx = cnt > 0u ? cnt : 1u;
}

__device__ __forceinline__ void xcd_barrier(const XcdBarrier& b) {
    asm volatile("s_waitcnt vmcnt(0)" ::: "memory");
    __syncthreads();
    if (threadIdx.x == 0) {
        unsigned* bar = b.bar;
        __builtin_amdgcn_s_waitcnt(0);
        unsigned nloc = b.st[0], nx = b.st[1];
        if (nloc == 0u) { xcd_barrier_complete(bar, b.x, nloc, nx); b.st[0] = nloc; b.st[1] = nx; }
        const unsigned old = xb_add(&bar[XB_XSUB(b.x)], 1u);
        const unsigned gen = old / nloc;
        if (old + 1u == (gen + 1u) * nloc) {
            __builtin_amdgcn_fence(__ATOMIC_RELEASE, "agent");
            asm volatile("s_waitcnt vmcnt(0)" ::: "memory");
            const unsigned og = xb_add(&bar[XB_TOP], 1u);
            const unsigned tg = og / nx;
            if (og + 1u == (tg + 1u) * nx) xb_add(&bar[XB_TOPGEN], 1u);
            else XB_SPIN(xb_ld(&bar[XB_TOPGEN]) == tg, bar);
            __builtin_amdgcn_fence(__ATOMIC_ACQUIRE, "agent");
            xb_add(&bar[XB_XGEN(b.x)], 1u);
            asm volatile("s_waitcnt vmcnt(0)" ::: "memory");
        } else {
            XB_SPIN(xb_ld(&bar[XB_XGEN(b.x)]) == gen, bar);
            __builtin_amdgcn_fence(__ATOMIC_ACQUIRE, "agent");
            asm volatile("s_waitcnt vmcnt(0)" ::: "memory");
        }
    }
    __syncthreads();
}
struct Frame {
    LAS unsigned char* lds;
    volatile LAS unsigned* MISC;
    gu32* ctl;
    int tid, lane, wave;
    int vcu, G;
    const float* x; float* out;
    const float *norm_mix_g, *w_in, *b_forget, *conv_dw_w, *conv_dw_b, *conv_ln_g, *conv_ln_b, *w_conv_pw, *b_conv_pw, *attn_out_g, *conv_out_g, *w_out, *norm_ffn_g, *w_up, *w_dn, *norm_final_g;
    bf16 *WIN_t, *WPW_t, *WOUT_t, *WUP_t, *WDN_t;
    bf16 *XN, *QB, *KB, *VB, *UB, *UC, *CAT, *HB;
    float *LPRE, *CHT, *SSQ1, *SSQ2;
};

__device__ __forceinline__ float wave_sum(float v) {
#pragma unroll
    for (int o = 1; o < 64; o <<= 1) v += __shfl_xor(v, o);
    return v;
}
__device__ __forceinline__ void p0_transpose_item(const float* W, int ldw, int srcn0, int k0, const float* ks, bf16* WT, int K, int dstn0, LAS float* scr, int lane) {
#pragma unroll 8
    for (int i = 0; i < 32; ++i) { const int kk = 2 * i + (lane >> 5); float v = W[(size_t)(k0 + kk) * ldw + srcn0 + (lane & 31)]; if (ks) v *= ks[k0 + kk]; scr[kk * 33 + (lane & 31)] = v; }
    LDS_WAIT(); asm volatile("" ::: "memory");
    const int c = lane & 7;
#pragma unroll
    for (int j = 0; j < 4; ++j) { const int n = (lane >> 3) + 8 * j; const LAS float* s = scr + (8 * c) * 33 + n;
        v4u o; o.x = pk2(s[0 * 33], s[1 * 33]); o.y = pk2(s[2 * 33], s[3 * 33]); o.z = pk2(s[4 * 33], s[5 * 33]); o.w = pk2(s[6 * 33], s[7 * 33]);
        *(GAS v4u*)(WT + (size_t)(dstn0 + n) * K + k0 + 8 * c) = o; }
    LDS_WAIT(); asm volatile("" ::: "memory");
}
__device__ __forceinline__ int win_src_col(int n0) { if (n0 < 3 * AW) return n0; const int r = n0 - 3 * AW, j = r >> 8, w = r & 255; return (w < 128) ? (3 * AW + 128 * j + w) : (3 * AW + CW + 128 * j + (w - 128)); }
__device__ __forceinline__ float log_sigmoid_f(float x) { return fminf(x, 0.f) - log1pf(expf(-fabsf(x))); }

__device__ __forceinline__ void p0_prologue(Frame& F) {
    LAS float* scr = (LAS float*)(F.lds + RING_OFF + F.wave * 16384);
    const int gw = F.vcu * NWAVES + F.wave, NGW = F.G * NWAVES;
    constexpr int I_IN = (D / 64) * (NPROJ / 32), I_PW = (CW / 64) * (CW / 32), I_OUT = (D / 64) * (D / 32), I_UP = (D / 64) * (FF / 32), I_DN = (FF / 64) * (D / 32);
    constexpr int NITEMS = I_IN + I_PW + I_OUT + I_UP + I_DN;
    for (int it = gw; it < NITEMS; it += NGW) {
        int r = it;
        if (r < I_IN) { const int nb = NPROJ / 32, kb = r / nb, n0 = 32 * (r % nb); p0_transpose_item(F.w_in, IN_COLS, win_src_col(n0), 64 * kb, nullptr, F.WIN_t, D, n0, scr, F.lane); continue; } r -= I_IN;
        if (r < I_PW) { const int nb = CW / 32, kb = r / nb, n0 = 32 * (r % nb); p0_transpose_item(F.w_conv_pw, CW, n0, 64 * kb, nullptr, F.WPW_t, CW, n0, scr, F.lane); continue; } r -= I_PW;
        if (r < I_OUT) { const int nb = D / 32, kb = r / nb, n0 = 32 * (r % nb); p0_transpose_item(F.w_out, D, n0, 64 * kb, nullptr, F.WOUT_t, D, n0, scr, F.lane); continue; } r -= I_OUT;
        if (r < I_UP) { const int nb = FF / 32, kb = r / nb, n0 = 32 * (r % nb); p0_transpose_item(F.w_up, FF, n0, 64 * kb, F.norm_ffn_g, F.WUP_t, D, n0, scr, F.lane); continue; } r -= I_UP;
        { const int nb = D / 32, kb = r / nb, n0 = 32 * (r % nb); p0_transpose_item(F.w_dn, D, n0, 64 * kb, nullptr, F.WDN_t, FF, n0, scr, F.lane); }
    }
    __syncthreads();
    LAS float* SCAN = (LAS float*)(F.lds + RING_OFF);
    LAS float* WTOT = SCAN + 1024;
    f32x4 gv[4]; f32x4 wf[4][4][2];
#pragma unroll
    for (int j = 0; j < 4; ++j) { gv[j] = *(const GAS f32x4*)(F.norm_mix_g + 4 * F.lane + 256 * j);
#pragma unroll
        for (int i = 0; i < 4; ++i) { const float* wp = F.w_in + (size_t)(4 * F.lane + i + 256 * j) * IN_COLS + NPROJ; wf[j][i][0] = *(const GAS f32x4*)wp; wf[j][i][1] = *(const GAS f32x4*)(wp + 4); } }
    const int hsel = F.lane & 7; const float bfv = F.b_forget[hsel];
    for (int ck = F.vcu; ck < M / 128; ck += F.G) {
        float pref = 0.f;
        for (int r = 0; r < 16; ++r) {
            const int row = 128 * ck + 16 * F.wave + r;
            const GAS f32x4* xr = (const GAS f32x4*)(F.x + (size_t)row * D) + F.lane;
            f32x4 v[4]; float s = 0.f;
#pragma unroll
            for (int j = 0; j < 4; ++j) { v[j] = xr[64 * j]; s += (v[j].x * v[j].x + v[j].y * v[j].y) + (v[j].z * v[j].z + v[j].w * v[j].w); }
            const float rstd = 1.0f / sqrtf(wave_sum(s) * (1.0f / D) + EPS);
            float d[8] = {0.f, 0.f, 0.f, 0.f, 0.f, 0.f, 0.f, 0.f};
            GAS unsigned long long* o8 = (GAS unsigned long long*)(F.XN + (size_t)row * D) + F.lane;
#pragma unroll
            for (int j = 0; j < 4; ++j) { v[j] = v[j] * rstd * gv[j];
                o8[64 * j] = (unsigned long long)pk2(v[j].x, v[j].y) | ((unsigned long long)pk2(v[j].z, v[j].w) << 32);
#pragma unroll
                for (int i = 0; i < 4; ++i) {
#pragma unroll
                    for (int hh = 0; hh < 4; ++hh) { d[hh] += v[j][i] * wf[j][i][0][hh]; d[4 + hh] += v[j][i] * wf[j][i][1][hh]; } } }
#pragma unroll
            for (int hh = 0; hh < 8; ++hh) d[hh] = wave_sum(d[hh]);
            float mine = d[0];
#pragma unroll
            for (int hh = 1; hh < 8; ++hh) mine = (hsel == hh) ? d[hh] : mine;
            pref += log_sigmoid_f(mine + bfv);
            if (F.lane < 8) SCAN[(16 * F.wave + r) * 8 + F.lane] = pref;
        }
        if (F.lane < 8) WTOT[F.wave * 8 + F.lane] = pref;
        __syncthreads();
#pragma unroll
        for (int q = 0; q < 2; ++q) { const int idx = F.tid + 512 * q, rr = idx >> 3, hh = idx & 7, w2 = rr >> 4; float off = 0.f;
            for (int w = 0; w < w2; ++w) off += WTOT[w * 8 + hh];
            F.LPRE[(size_t)(128 * ck + rr) * 8 + hh] = SCAN[idx] + off; }
        if (F.tid < 8) { float tot = 0.f; for (int w = 0; w < 8; ++w) tot += WTOT[w * 8 + F.tid]; F.CHT[ck * 8 + F.tid] = tot; }
        __syncthreads();
    }
}

__device__ __forceinline__ void p2_conv_prep(Frame& F) {
    typedef float f32x2v __attribute__((ext_vector_type(2)));
    LAS unsigned char* UT = F.lds + RING_OFF;
    LAS float* CT = (LAS float*)(F.lds + RING_OFF + 62 * 512 * 2);
    constexpr int NIT = M / 32;
    const int cp = F.tid & 255, half = F.tid >> 8;
    f32x2v w[CK];
#pragma unroll
    for (int j = 0; j < CK; ++j) w[j] = *(const GAS f32x2v*)(F.conv_dw_w + j * CW + 2 * cp);
    const f32x2v bdw = *(const GAS f32x2v*)(F.conv_dw_b + 2 * cp);
    f32x4 lg[2], lb[2];
#pragma unroll
    for (int q = 0; q < 2; ++q) { lg[q] = *(const GAS f32x4*)(F.conv_ln_g + 8 * F.lane + 4 * q); lb[q] = *(const GAS f32x4*)(F.conv_ln_b + 8 * F.lane + 4 * q); }
    for (int it = F.vcu; it < NIT; it += F.G) {
        const int b = it / (T / 32), t0 = (it % (T / 32)) * 32;
        for (int vv = F.tid; vv < 62 * 64; vv += 512) { const int rr = vv >> 6, cv = vv & 63, tt = t0 - 30 + rr;
            v4u val = (v4u){0u, 0u, 0u, 0u};
            if (tt >= 0) val = *(const GAS v4u*)(F.UB + ((size_t)(b * T + tt) * CW + cv * 8));
            *(LAS v4u*)(UT + (size_t)vv * 16) = val; }
        __syncthreads();
#pragma unroll 1
        for (int blk = 0; blk < 2; ++blk) { const int ob = 16 * half + 8 * blk;
            f32x2v win[38];
#pragma unroll
            for (int i = 0; i < 38; ++i) { const unsigned pk = *(const LAS unsigned*)(UT + ((ob + i) * CW + 2 * cp) * 2); win[i] = (f32x2v){__uint_as_float(pk << 16), __uint_as_float(pk & 0xffff0000u)}; }
            f32x2v acc[8];
#pragma unroll
            for (int i = 0; i < 8; ++i) acc[i] = bdw;
#pragma unroll
            for (int j = 0; j < CK; ++j)
#pragma unroll
                for (int i = 0; i < 8; ++i) acc[i] += w[j] * win[i + j];
#pragma unroll
            for (int i = 0; i < 8; ++i) *(LAS f32x2v*)(CT + (ob + i) * CW + 2 * cp) = acc[i]; }
        __syncthreads();
#pragma unroll 1
        for (int q = 0; q < 4; ++q) { const int rr = 4 * F.wave + q;
            f32x4 v0 = *(const LAS f32x4*)(CT + rr * CW + 8 * F.lane), v1 = *(const LAS f32x4*)(CT + rr * CW + 8 * F.lane + 4);
            const float mean = wave_sum((v0.x + v0.y) + (v0.z + v0.w) + (v1.x + v1.y) + (v1.z + v1.w)) * (1.0f / CW);
            v0 = v0 - mean; v1 = v1 - mean;
            const float var = wave_sum((v0.x * v0.x + v0.y * v0.y) + (v0.z * v0.z + v0.w * v0.w) + (v1.x * v1.x + v1.y * v1.y) + (v1.z * v1.z + v1.w * v1.w)) * (1.0f / CW);
            const float rstd = 1.0f / sqrtf(var + EPS);
            v0 = v0 * rstd * lg[0] + lb[0]; v1 = v1 * rstd * lg[1] + lb[1];
#pragma unroll
            for (int e = 0; e < 4; ++e) { v0[e] *= pg8::sigmoid_f(v0[e]); v1[e] *= pg8::sigmoid_f(v1[e]); }
            v4u o; o.x = pk2(v0.x, v0.y); o.y = pk2(v0.z, v0.w); o.z = pk2(v1.x, v1.y); o.w = pk2(v1.z, v1.w);
            *(GAS v4u*)(F.UC + ((size_t)(it * 32 + rr) * CW + 8 * F.lane)) = o; }
        __syncthreads();
    }
}
__device__ __forceinline__ void p7_final_norm(Frame& F) {
    const int gw = F.vcu * NWAVES + F.wave, NGW = F.G * NWAVES;
    f32x4 gv[4];
#pragma unroll
    for (int j = 0; j < 4; ++j) gv[j] = *(const GAS f32x4*)(F.norm_final_g + 4 * F.lane + 256 * j);
    for (int m = gw; m < M; m += NGW) {
        GAS f32x4* xr = (GAS f32x4*)(F.out + (size_t)m * D) + F.lane;
        const f32x4 p = *(const GAS f32x4*)(F.SSQ2 + (size_t)m * 4);
        const float rstd = 1.0f / sqrtf(((p.x + p.y) + (p.z + p.w)) * (1.0f / D) + EPS);
        f32x4 v[4];
#pragma unroll
        for (int j = 0; j < 4; ++j) v[j] = xr[64 * j];
#pragma unroll
        for (int j = 0; j < 4; ++j) xr[64 * j] = v[j] * rstd * gv[j];
    }
}
struct Args { const float* in[17]; float* out; unsigned char* ws; int ph_lo, ph_hi, li, pad; };
__global__ void __launch_bounds__(NWAVES * 64, 2) mk_fwd(Args args) {
    extern __shared__ __attribute__((aligned(16))) unsigned char lds[];
    Frame F;
    F.lds = (LAS unsigned char*)lds;
    F.MISC = (volatile LAS unsigned*)(F.lds + MISC_OFF);
    F.tid = threadIdx.x; F.lane = F.tid & 63; F.wave = __builtin_amdgcn_readfirstlane(F.tid >> 6);
    F.G = gridDim.x; { const int bx = blockIdx.x; F.vcu = (F.G % 8 == 0) ? (bx % 8) * (F.G / 8) + bx / 8 : bx; }
#define GRID_BAR(seam) do { if (N_LAUNCHES == PER_PHASE) { if (F.tid == 0) __hip_atomic_store(F.ctl + CW_TMO, 0xBADBA0u | (unsigned)(seam), RLX_AGENT); } \
    else { xcd_barrier(bar); } } while (0)
    unsigned char* ws = args.ws;
    F.ctl = (gu32*)(ws + WS_CTL);
    F.x = args.in[0]; F.norm_mix_g = args.in[1]; F.w_in = args.in[2]; F.b_forget = args.in[3]; F.conv_dw_w = args.in[4]; F.conv_dw_b = args.in[5]; F.conv_ln_g = args.in[6]; F.conv_ln_b = args.in[7];
    F.w_conv_pw = args.in[8]; F.b_conv_pw = args.in[9]; F.attn_out_g = args.in[10]; F.conv_out_g = args.in[11]; F.w_out = args.in[12]; F.norm_ffn_g = args.in[13]; F.w_up = args.in[14]; F.w_dn = args.in[15];
    F.norm_final_g = args.in[16]; F.out = args.out;
    F.WIN_t = (bf16*)(ws + WS_WIN); F.WPW_t = (bf16*)(ws + WS_WPW); F.WOUT_t = (bf16*)(ws + WS_WOUT); F.WUP_t = (bf16*)(ws + WS_WUP); F.WDN_t = (bf16*)(ws + WS_WDN);
    F.XN = (bf16*)(ws + WS_XN); F.QB = (bf16*)(ws + WS_Q); F.KB = (bf16*)(ws + WS_K); F.VB = (bf16*)(ws + WS_V); F.UB = (bf16*)(ws + WS_U); F.UC = (bf16*)(ws + WS_UC); F.CAT = (bf16*)(ws + WS_CAT); F.HB = (bf16*)(ws + WS_H);
    F.LPRE = (float*)(ws + WS_LPRE); F.CHT = (float*)(ws + WS_CHT); F.SSQ1 = (float*)(ws + WS_SSQ1); F.SSQ2 = (float*)(ws + WS_SSQ2);
    for (int u = F.tid; u < (LDS_BYTES - LDSCTL_OFF) / 4; u += NWAVES * 64) ((LAS unsigned*)(F.lds + LDSCTL_OFF))[u] = 0u;
    __syncthreads();
    XcdBarrier bar; bar.bar = (unsigned*)(F.ctl + CW_BAR); bar.x = 0; bar.st = nullptr;
    if (N_LAUNCHES != PER_PHASE) bar = xcd_barrier_post((unsigned*)(F.ctl + CW_BAR), F.MISC + 8);
    const int lo = args.ph_lo, hi = args.ph_hi;
#define IN(k) (lo <= (k) && (k) < hi)
#define BOTH(k) (IN(k) && IN((k) + 1))
    LAS float* const scr_tab = (LAS float*)(F.lds + SCR_OFF);

    if (IN(0)) { p0_prologue(F); if (BOTH(0)) GRID_BAR(0); }

    if (IN(1)) {
        pg8::Gemm g{F.XN, F.WIN_t, M, NPROJ, D}; pg8::StaticOrder S; S.init(M, NPROJ, F.G, (int)blockIdx.x);
        pg8::EpiInProj E{F.QB, (size_t)(WS_K - WS_Q) / 2, F.UB, attn_body::C2};
        pg8::gemm_phase<pg8::EpiInProj, pg8::StaticOrder, PG8_ALIGN, PG8_SP2>(F.lds + RING_OFF, g, S, E);
        if (BOTH(1)) GRID_BAR(1);
    }

    if (IN(2)) {
        p2_conv_prep(F);
        static_assert(attn_body::ATTN_LDS_BYTES <= RING_BYTES && attn_body::ATTN_PITCH == AW, "attention body geometry vs frame");
        const attn_body::AttnTensors AT{(const attn_body::bf16*)F.QB, (const attn_body::bf16*)F.KB, (const attn_body::bf16*)F.VB, (attn_body::bf16*)F.CAT, F.LPRE, F.CHT, F.attn_out_g};
        const attn_body::StaticOrder S((int)F.G, F.vcu);
        attn_body::attn_phase<8>((char*)lds + RING_OFF, AT, S);
        if (BOTH(2)) GRID_BAR(2);
    }

    if (IN(3)) {
        pg8::Gemm g{F.UC, F.WPW_t, M, CW, CW}; pg8::StaticOrder S; S.init(M, CW, F.G, (int)blockIdx.x);
        pg8::EpiConvOut E{F.CAT, F.b_conv_pw, F.conv_out_g, EPS};
        if (F.G * 1 >= (M / 256) * (CW / 256)) pg8::gemm_phase<pg8::EpiConvOut, pg8::StaticOrder, false, PG8_SP2>(F.lds + RING_OFF, g, S, E);
        if (BOTH(3)) GRID_BAR(3);
    }

    if (IN(4)) {
        pg8::Gemm g{F.CAT, F.WOUT_t, M, D, D}; pg8::StaticOrder S; S.init(M, D, F.G, (int)blockIdx.x);
        pg8::EpiRes<0> E{F.x, F.out, F.XN, F.SSQ1, nullptr, scr_tab, EPS};
        pg8::gemm_phase<pg8::EpiRes<0>, pg8::StaticOrder, true, PG8_SP2>(F.lds + RING_OFF, g, S, E);
        if (BOTH(4)) GRID_BAR(4);
    }

    if (IN(5)) {
        pg8::Gemm g{F.XN, F.WUP_t, M, FF, D}; pg8::StaticOrder S; S.init(M, FF, F.G, (int)blockIdx.x);
        pg8::EpiRelu2 E{F.HB, FF};
        pg8::gemm_phase<pg8::EpiRelu2, pg8::StaticOrder, PG8_ALIGN, PG8_SP2>(F.lds + RING_OFF, g, S, E);
        if (BOTH(5)) GRID_BAR(5);
    }

    if (IN(6)) {
        pg8::Gemm g{F.HB, F.WDN_t, M, D, FF}; pg8::StaticOrder S; S.init(M, D, F.G, (int)blockIdx.x);
        pg8::EpiRes<1> E{F.out, F.out, nullptr, F.SSQ2, F.SSQ1, scr_tab, EPS};
        pg8::gemm_phase<pg8::EpiRes<1>, pg8::StaticOrder, true, PG8_SP2>(F.lds + RING_OFF, g, S, E);
        if (BOTH(6)) GRID_BAR(6);
    }

    if (IN(7)) {
        unsigned poison = (__hip_atomic_load(F.ctl + CW_TMO, RLX_AGENT) != 0u) | (__hip_atomic_load((gu32*)((const unsigned*)(F.ctl + CW_BAR) + XB_TMO), RLX_AGENT) != 0u);
        p7_final_norm(F);
        if (poison) { const int gw = F.vcu * NWAVES + F.wave, NGW = F.G * NWAVES; const float q = __builtin_nanf("");
            for (int m = gw; m < M; m += NGW) { GAS f32x4* o = (GAS f32x4*)(F.out + (size_t)m * D) + F.lane;
#pragma unroll
                for (int j = 0; j < 4; ++j) o[64 * j] = (f32x4){q, q, q, q}; } }
    }
#undef IN
#undef BOTH
}

extern "C" void kernel_launch(void* const* d_in, const int* in_sizes, int n_in, void* d_out, int out_size, void* d_ws, size_t ws_size, hipStream_t stream) {
    static int grid = 0;
    if (grid == 0) {
        if (n_in != 17 || in_sizes[0] != M * D || out_size != M * D || ws_size < WS_END) { fprintf(stderr, "kernel_launch: built for 17 inputs, x and out of %d floats, >= %zu bytes of workspace; got n_in %d, in0 %d, out %d, ws %zu; nothing launched\n", M * D, (size_t)WS_END, n_in, n_in > 0 ? in_sizes[0] : -1, out_size, ws_size); grid = -1; return; }
        int dev = 0, cus = 0, per_cu = 0;
        if (hipGetDevice(&dev) != hipSuccess || hipDeviceGetAttribute(&cus, hipDeviceAttributeMultiprocessorCount, dev) != hipSuccess) { fprintf(stderr, "kernel_launch: hipGetDevice / hipDeviceGetAttribute failed\n"); grid = -1; return; }
        if (hipFuncSetAttribute((const void*)mk_fwd, hipFuncAttributeMaxDynamicSharedMemorySize, LDS_BYTES) != hipSuccess) { fprintf(stderr, "kernel_launch: hipFuncSetAttribute failed\n"); grid = -1; return; }
        if (hipOccupancyMaxActiveBlocksPerMultiprocessor(&per_cu, (const void*)mk_fwd, NWAVES * 64, LDS_BYTES) != hipSuccess || per_cu < 1)
            fprintf(stderr, "kernel_launch: note: the occupancy query reports %d workgroups per CU\n", per_cu);
        (void)hipGetLastError();
        grid = cus;
        if (grid > 256) grid = 256;
    }
    if (grid < 0) return;
    if (hipMemsetAsync((char*)d_ws + WS_CTL, 0, CTL_ZERO_BYTES, stream) != hipSuccess) { fprintf(stderr, "kernel_launch: hipMemsetAsync failed\n"); return; }
    Args a{};
    for (int i = 0; i < 17; ++i) a.in[i] = (const float*)d_in[i];
    a.out = (float*)d_out; a.ws = (unsigned char*)d_ws;
    for (int li = 0; li < N_LAUNCHES; ++li) {
        a.ph_lo = (N_LAUNCHES == PER_PHASE) ? li : 0; a.ph_hi = (N_LAUNCHES == PER_PHASE) ? li + 1 : PER_PHASE; a.li = li;
        hipLaunchKernelGGL(mk_fwd, dim3(grid), dim3(NWAVES * 64), LDS_BYTES, stream, a);
        const hipError_t le = hipPeekAtLastError();
        if (le != hipSuccess) { fprintf(stderr, "kernel_launch: launch %d failed: %s\n", li, hipGetErrorName(le)); break; }
    }
}
```

```cpp
#include <hip/hip_runtime.h>
#include <cstdio>
#include <cstdint>
namespace pg8 {
#define PG8_LAS __attribute__((address_space(3)))
typedef unsigned short bf16_t;
typedef short bf16x8 __attribute__((ext_vector_type(8)));
typedef float f32x4 __attribute__((ext_vector_type(4)));
typedef unsigned u32x4 __attribute__((ext_vector_type(4)));
constexpr int BM = 256, BK = 64, HALF = 128, HTB = HALF * BK * 2  , STAGE_BYTES = 8 * HTB, NXCD = 8, WGM = 8;

__host__ __device__ __forceinline__ int lds_byte(int r, int c) { const int st = (r >> 4) * 2 + (c >> 5), rr = r & 15, cc = c & 31, ob = rr * 64 + cc * 2; return st * 1024 + (ob ^ (((ob >> 9) & 1) << 5)); }
__host__ __device__ __forceinline__ void stage_rc(int b, int& R, int& C) { const int st = b / 1024, sb = b % 1024, swz = sb ^ (((sb >> 9) & 1) << 5); R = (st >> 1) * 16 + swz / 64; C = (st & 1) * 32 + (swz % 64) / 2; }
__host__ __device__ __forceinline__ int perm32(int rho) { const int n = rho >> 4, i = rho & 15; return 8 * (i >> 2) + 4 * n + (i & 3); }

struct Unit { int pm, pn; };
struct Gemm { const bf16_t* A; const bf16_t* Bt; int M, N, K; };

struct StaticOrder {
    int nM, nN, nwg, G, c;
    __host__ __device__ void init(int M, int N, int G_, int c_) { nM = M / BM; nN = N / BM; nwg = nM * nN; G = G_; c = c_; }
    __host__ __device__ bool next(int i, Unit& u) const {
        const long L = (long)i * G + c; if (L >= nwg) return false;
        int wgid = (int)L; { const int q = nwg / NXCD, r = nwg % NXCD, xcd = wgid % NXCD, off = wgid / NXCD; wgid = (xcd < r ? xcd * (q + 1) : r * (q + 1) + (xcd - r) * q) + off; }
        const int nig = WGM * nN, gid = wgid / nig, fm = gid * WGM, gsz = (nM - fm) < WGM ? (nM - fm) : WGM;
        u.pm = fm + ((wgid % nig) % gsz); u.pn = (wgid % nig) / gsz; return true;
    }
    __device__ __forceinline__ void a_ready(const Unit&) const {}
    __device__ __forceinline__ void done(const Unit&) const {}
};

__device__ __forceinline__ unsigned cvt_pk_bf16(float lo, float hi) { unsigned r; asm volatile("v_cvt_pk_bf16_f32 %0, %1, %2" : "=v"(r) : "v"(lo), "v"(hi)); return r; }
typedef float f32x2 __attribute__((ext_vector_type(2)));
constexpr float LOG2E_F = 1.4426950408889634f;
__device__ __forceinline__ float sigmoid_f(float x) { return __builtin_amdgcn_rcpf(1.0f + __builtin_amdgcn_exp2f(-x * LOG2E_F)); }
#define PG8_LDSBAR() do { asm volatile("s_waitcnt lgkmcnt(0)" ::: "memory"); __builtin_amdgcn_s_barrier(); asm volatile("" ::: "memory"); } while (0)

struct EpiInProj {
    static constexpr bool PERM = true, AFTER_DRAIN = false;
    bf16_t* QKV; size_t stride; bf16_t* U; float qscale;
    __device__ __forceinline__ void operator()(const f32x4 (&acc)[2][2][4][2], const Unit& u, int wr, int wc, int fr, int fq) const {
        const int row0 = u.pm * BM + wr * 64 + fr;
        if (u.pn < 6) {
            const int t = u.pn >> 1; bf16_t* base = QKV + (size_t)t * stride; const float sc = (t == 0) ? qscale : 1.f;
            const int col0 = (u.pn & 1) * BM + wc * 32 + 8 * fq;
#pragma unroll
            for (int ai = 0; ai < 2; ++ai)
#pragma unroll
                for (int m = 0; m < 4; ++m) { bf16_t* rowp = base + (size_t)(row0 + ai * HALF + m * 16) * 512 + col0;
#pragma unroll
                    for (int bj = 0; bj < 2; ++bj) { const f32x4 v0 = acc[ai][bj][m][0] * sc, v1 = acc[ai][bj][m][1] * sc;
                        u32x4 w; w.x = cvt_pk_bf16(v0[0], v0[1]); w.y = cvt_pk_bf16(v0[2], v0[3]); w.z = cvt_pk_bf16(v1[0], v1[1]); w.w = cvt_pk_bf16(v1[2], v1[3]);
                        *(u32x4*)(rowp + bj * HALF) = w; } }
        } else {
            const int col0 = (u.pn - 6) * HALF + wc * 32 + 8 * fq;
#pragma unroll
            for (int ai = 0; ai < 2; ++ai)
#pragma unroll
                for (int m = 0; m < 4; ++m) { bf16_t* rowp = U + (size_t)(row0 + ai * HALF + m * 16) * 512 + col0;
                    f32x4 g0 = acc[ai][0][m][0], g1 = acc[ai][0][m][1]; const f32x4 s0 = acc[ai][1][m][0], s1 = acc[ai][1][m][1];
#pragma unroll
                    for (int e = 0; e < 4; ++e) { g0[e] *= sigmoid_f(s0[e]); g1[e] *= sigmoid_f(s1[e]); }
                    u32x4 w; w.x = cvt_pk_bf16(g0[0], g0[1]); w.y = cvt_pk_bf16(g0[2], g0[3]); w.z = cvt_pk_bf16(g1[0], g1[1]); w.w = cvt_pk_bf16(g1[2], g1[3]);
                    *(u32x4*)rowp = w; }
        }
    }
};
struct EpiRelu2 {
    static constexpr bool PERM = true, AFTER_DRAIN = false;
    bf16_t* O; int ldc;
    __device__ __forceinline__ void operator()(const f32x4 (&acc)[2][2][4][2], const Unit& u, int wr, int wc, int fr, int fq) const {
        const int row0 = u.pm * BM + wr * 64 + fr, col0 = u.pn * BM + wc * 32 + 8 * fq;
#pragma unroll
        for (int ai = 0; ai < 2; ++ai)
#pragma unroll
            for (int m = 0; m < 4; ++m) { bf16_t* rowp = O + (size_t)(row0 + ai * HALF + m * 16) * ldc + col0;
#pragma unroll
                for (int bj = 0; bj < 2; ++bj) { f32x4 v0 = acc[ai][bj][m][0], v1 = acc[ai][bj][m][1];
#pragma unroll
                    for (int e = 0; e < 4; ++e) { const float a = __builtin_fmaxf(v0[e], 0.f), b = __builtin_fmaxf(v1[e], 0.f); v0[e] = a * a; v1[e] = b * b; }
                    u32x4 w; w.x = cvt_pk_bf16(v0[0], v0[1]); w.y = cvt_pk_bf16(v0[2], v0[3]); w.z = cvt_pk_bf16(v1[0], v1[1]); w.w = cvt_pk_bf16(v1[2], v1[3]);
                    *(u32x4*)(rowp + bj * HALF) = w; } }
    }
};
template <int MODE> struct EpiRes {
    static constexpr bool PERM = false, AFTER_DRAIN = false;
    const float* base; const bf16_t* baseb; float* out; bf16_t* xb; float* ssq; const float* ssq_in; PG8_LAS float* sc; float eps;
    __device__ __forceinline__ void operator()(const f32x4 (&acc)[2][2][4][2], const Unit& u, int wr, int wc, int fr, int fq) const {
        typedef unsigned u32x2v __attribute__((ext_vector_type(2)));
        const int col0 = u.pn * BM + wc * 32 + 4 * fq;
#pragma unroll
        for (int ai = 0; ai < 2; ++ai)
#pragma unroll
            for (int m = 0; m < 4; ++m) { const int r = ai * HALF + wr * 64 + m * 16 + fr; const size_t off = (size_t)(u.pm * BM + r) * 1024 + col0;
                float r2 = 1.f;
                if (MODE == 1) { const f32x4 p = *(const f32x4*)(ssq_in + (size_t)(u.pm * BM + r) * 4); r2 = 1.0f / (((p[0] + p[1]) + (p[2] + p[3])) * (1.0f / 1024.0f) + eps); }
                float ss = 0.f;
#pragma unroll
                for (int bj = 0; bj < 2; ++bj)
#pragma unroll
                    for (int n = 0; n < 2; ++n) { f32x4 bs;
                        if (MODE == 0) bs = *(const f32x4*)(base + off + bj * HALF + n * 16);
                        else { const u32x2v rb = *(const u32x2v*)(baseb + off + bj * HALF + n * 16); bs = (f32x4){__uint_as_float(rb.x << 16), __uint_as_float(rb.x & 0xffff0000u), __uint_as_float(rb.y << 16), __uint_as_float(rb.y & 0xffff0000u)}; }
                        const f32x4 o = bs + acc[ai][bj][m][n] * r2;
                        ss += (o[0] * o[0] + o[1] * o[1]) + (o[2] * o[2] + o[3] * o[3]);
                        if (MODE == 0) { u32x2v w; w.x = cvt_pk_bf16(o[0], o[1]); w.y = cvt_pk_bf16(o[2], o[3]); *(u32x2v*)(xb + off + bj * HALF + n * 16) = w; }
                        else *(f32x4*)(out + off + bj * HALF + n * 16) = o; }
                ss += __shfl_xor(ss, 16); ss += __shfl_xor(ss, 32);
                if (fq == 0) sc[r * 4 + wc] = ss;
                if (m & 1) asm volatile("" ::: "memory"); }
        PG8_LDSBAR();
        const int tid = threadIdx.x;
        if (tid < 256) { const f32x4 p = *(const PG8_LAS f32x4*)(sc + tid * 4); ssq[(size_t)(u.pm * BM + tid) * 4 + u.pn] = (p[0] + p[1]) + (p[2] + p[3]); }
    }
};
struct EpiConvOut {
    static constexpr bool PERM = true, AFTER_DRAIN = true;
    bf16_t* cat; const float* bias; const float* g; float eps;
    __device__ __forceinline__ void fused(f32x4 (&acc)[2][2][4][2], const Unit& u, int wr, int wc, int fr, int fq, PG8_LAS unsigned char* lds, int wid, int lane) const {
        PG8_LAS float* sc = (PG8_LAS float*)lds;
        const int cb = u.pn * BM + wc * 32 + 8 * fq;
        f32x4 gv[2][2];
#pragma unroll
        for (int bj = 0; bj < 2; ++bj)
#pragma unroll
            for (int n = 0; n < 2; ++n) { const f32x4 bv = *(const f32x4*)(bias + cb + bj * HALF + 4 * n); gv[bj][n] = *(const f32x4*)(g + cb + bj * HALF + 4 * n);
#pragma unroll
                for (int ai = 0; ai < 2; ++ai)
#pragma unroll
                    for (int m = 0; m < 4; ++m) acc[ai][bj][m][n] += bv; }
#pragma unroll
        for (int ai = 0; ai < 2; ++ai)
#pragma unroll
            for (int m = 0; m < 4; ++m) { const int r = ai * HALF + wr * 64 + m * 16 + fr;
#pragma unroll
                for (int bj = 0; bj < 2; ++bj) { const f32x4 a = acc[ai][bj][m][0], b = acc[ai][bj][m][1];
                    float s = ((a[0] * a[0] + a[1] * a[1]) + (a[2] * a[2] + a[3] * a[3])) + ((b[0] * b[0] + b[1] * b[1]) + (b[2] * b[2] + b[3] * b[3]));
                    s += __shfl_xor(s, 16); s += __shfl_xor(s, 32);
                    if (fq == 0) sc[(r * 2 + bj) * 4 + wc] = s; } }
        PG8_LDSBAR();
#pragma unroll
        for (int ai = 0; ai < 2; ++ai)
#pragma unroll
            for (int m = 0; m < 4; ++m) { const int r = ai * HALF + wr * 64 + m * 16 + fr; bf16_t* rowp = cat + (size_t)(u.pm * BM + r) * 1024 + 512 + cb;
#pragma unroll
                for (int bj = 0; bj < 2; ++bj) { const float tot = sc[(r * 2 + bj) * 4 + wc] + sc[(r * 2 + bj) * 4 + (wc ^ 1)];
                    const float rs = 1.0f / sqrtf(tot * (1.0f / 64.0f) + eps);
                    const f32x4 v0 = acc[ai][bj][m][0] * rs * gv[bj][0], v1 = acc[ai][bj][m][1] * rs * gv[bj][1];
                    u32x4 w; w.x = cvt_pk_bf16(v0[0], v0[1]); w.y = cvt_pk_bf16(v0[2], v0[3]); w.z = cvt_pk_bf16(v1[0], v1[1]); w.w = cvt_pk_bf16(v1[2], v1[3]);
                    *(u32x4*)(rowp + bj * HALF) = w; } }
    }
};

template <class Epi, class Sched, bool ALIGN_EPI = false, bool SP2 = false>
__device__ __forceinline__ void gemm_phase(PG8_LAS unsigned char* lds, const Gemm g, const Sched& S, const Epi& E) {
    const int tid = threadIdx.x, wid = __builtin_amdgcn_readfirstlane(tid >> 6), lane = tid & 63, wr = wid >> 2, wc = wid & 3, fr = lane & 15, fq = lane >> 4;
    const int K = g.K, nt = K / BK;
    unsigned voffA[2], voffB[2];
#pragma unroll
    for (int i = 0; i < 2; ++i) { int R, C; stage_rc(tid * 16 + i * 8192, R, C); const int Rb = Epi::PERM ? ((R & ~31) + perm32(R & 31)) : R;
        voffA[i] = (unsigned)(R * K + C) * 2u; voffB[i] = (unsigned)(Rb * K + C) * 2u; }
    const size_t kstep = (size_t)(BK * 2);
    const size_t hstep = (size_t)HALF * K * 2;
    const size_t tstep = 2 * hstep;
    const unsigned ldsw = (unsigned)wid * 1024u;
    const int aoff = lds_byte(wr * 64 + fr, fq * 8), boff = lds_byte(wc * 32 + fr, fq * 8);
#define PG8_SA(b, h) (((b) * 2 + (h)) * HTB)
#define PG8_SB(b, h) ((4 + (b) * 2 + (h)) * HTB)
#define PG8_STAGE(bufoff, gbase, voff) do { _Pragma("unroll") for (int _i = 0; _i < 2; ++_i) \
        __builtin_amdgcn_global_load_lds((const unsigned*)((const char*)(gbase) + (voff)[_i]), (PG8_LAS unsigned*)(lds + (bufoff) + ldsw + _i * 8192), 16, 0, 0); } while (0)
#define PG8_LDA(dst, b, h) do { _Pragma("unroll") for (int m = 0; m < 4; ++m) _Pragma("unroll") for (int k = 0; k < 2; ++k) dst[m][k] = *(const PG8_LAS bf16x8*)(lds + PG8_SA(b, h) + aoff + m * 2048 + k * 1024); } while (0)
#define PG8_LDB(dst, b, h) do { _Pragma("unroll") for (int n = 0; n < 2; ++n) _Pragma("unroll") for (int k = 0; k < 2; ++k) dst[n][k] = *(const PG8_LAS bf16x8*)(lds + PG8_SB(b, h) + boff + n * 2048 + k * 1024); } while (0)
#define PG8_MMA(ai, bj, At, Bt) do { __builtin_amdgcn_s_setprio(1); _Pragma("unroll") for (int m = 0; m < 4; ++m) _Pragma("unroll") for (int n = 0; n < 2; ++n) _Pragma("unroll") for (int k = 0; k < 2; ++k) \
        acc[ai][bj][m][n] = __builtin_amdgcn_mfma_f32_16x16x32_bf16(Bt[n][k], At[m][k], acc[ai][bj][m][n], 0, 0, 0); __builtin_amdgcn_s_setprio(0); } while (0)
#define PG8_WAIT_V(n) asm volatile("s_waitcnt vmcnt(" #n ")" ::: "memory")
#define PG8_WAIT_L(n) asm volatile("s_waitcnt lgkmcnt(" #n ")" ::: "memory")
#define PG8_BAR __builtin_amdgcn_s_barrier()
#define PG8_SCHED __builtin_amdgcn_sched_barrier(0)
    Unit cur, nxt; int ui = 0;
    if (!S.next(0, cur)) return;
    f32x4 acc[2][2][4][2];
#pragma unroll
    for (int a = 0; a < 2; ++a)
#pragma unroll
        for (int b = 0; b < 2; ++b)
#pragma unroll
            for (int m = 0; m < 4; ++m)
#pragma unroll
                for (int n = 0; n < 2; ++n) acc[a][b][m][n] = (f32x4){0.f, 0.f, 0.f, 0.f};
    bf16x8 At[4][2], B0[2][2], B1[2][2];
    const char* cA = (const char*)g.A + (size_t)cur.pm * tstep; const char* cB = (const char*)g.Bt + (size_t)cur.pn * tstep;
    S.a_ready(cur);
    if constexpr (SP2) {
        PG8_STAGE(PG8_SB(0, 0), cB, voffB); PG8_STAGE(PG8_SB(0, 1), cB + hstep, voffB); PG8_STAGE(PG8_SA(0, 0), cA, voffA); PG8_STAGE(PG8_SA(0, 1), cA + hstep, voffA);
        if (wr == 1) PG8_BAR;
        PG8_WAIT_V(2); PG8_BAR;
        PG8_STAGE(PG8_SB(1, 0), cB + kstep, voffB); PG8_STAGE(PG8_SA(1, 0), cA + kstep, voffA); PG8_STAGE(PG8_SB(1, 1), cB + hstep + kstep, voffB);
        PG8_WAIT_V(6); PG8_BAR;
    } else {
        PG8_STAGE(PG8_SB(0, 0), cB, voffB); PG8_STAGE(PG8_SA(0, 0), cA, voffA); PG8_STAGE(PG8_SB(0, 1), cB + hstep, voffB); PG8_STAGE(PG8_SA(0, 1), cA + hstep, voffA);
        if (wr == 1) PG8_BAR;
        PG8_WAIT_V(4); PG8_BAR;
        PG8_STAGE(PG8_SB(1, 0), cB + kstep, voffB); PG8_STAGE(PG8_SA(1, 0), cA + kstep, voffA); PG8_STAGE(PG8_SB(1, 1), cB + hstep + kstep, voffB);
        PG8_WAIT_V(6); PG8_BAR;
    }
    for (;;) {
        const bool has_next = S.next(ui + 1, nxt);
        const char* nA = has_next ? (const char*)g.A + (size_t)nxt.pm * tstep : cA; const char* nB = has_next ? (const char*)g.Bt + (size_t)nxt.pn * tstep : cB;
        for (int t = 0; t < nt; t += 2) {
            const bool last = (t == nt - 2);
            const char* a1 = cA + (size_t)(t + 1) * kstep;
            const char* a2 = last ? nA : cA + (size_t)(t + 2) * kstep; const char* b2 = last ? nB : cB + (size_t)(t + 2) * kstep;
            const char* a3 = a2 + kstep; const char* b3 = b2 + kstep;
            if (last && has_next) S.a_ready(nxt);
            if constexpr (SP2) {
            PG8_LDB(B0, 0, 0); PG8_LDB(B1, 0, 1); PG8_SCHED; PG8_LDA(At, 0, 0); PG8_STAGE(PG8_SA(1, 1), a1 + hstep, voffA);
            PG8_WAIT_V(8); PG8_WAIT_L(0); PG8_BAR; PG8_MMA(0, 0, At, B0); PG8_MMA(0, 1, At, B1); PG8_BAR; PG8_SCHED;
            PG8_LDA(At, 0, 1); PG8_STAGE(PG8_SB(0, 0), b2, voffB); PG8_STAGE(PG8_SB(0, 1), b2 + hstep, voffB); PG8_STAGE(PG8_SA(0, 0), a2, voffA);
            PG8_WAIT_V(8); PG8_WAIT_L(0); PG8_BAR; PG8_MMA(1, 0, At, B0); PG8_MMA(1, 1, At, B1); PG8_BAR; PG8_SCHED;
            PG8_LDB(B0, 1, 0); PG8_LDB(B1, 1, 1); PG8_SCHED; PG8_LDA(At, 1, 0); PG8_STAGE(PG8_SA(0, 1), a2 + hstep, voffA);
            PG8_WAIT_V(8); PG8_WAIT_L(0); PG8_BAR; PG8_MMA(0, 0, At, B0); PG8_MMA(0, 1, At, B1); PG8_BAR; PG8_SCHED;
            PG8_LDA(At, 1, 1); PG8_STAGE(PG8_SB(1, 0), b3, voffB); PG8_STAGE(PG8_SB(1, 1), b3 + hstep, voffB); PG8_STAGE(PG8_SA(1, 0), a3, voffA);
            PG8_WAIT_V(8); PG8_WAIT_L(0); PG8_BAR; PG8_MMA(1, 0, At, B0); PG8_MMA(1, 1, At, B1); PG8_BAR; PG8_SCHED;
            } else {
            PG8_LDB(B0, 0, 0); PG8_SCHED; PG8_LDA(At, 0, 0); PG8_STAGE(PG8_SA(1, 1), a1 + hstep, voffA);
            PG8_WAIT_L(8); PG8_BAR; PG8_WAIT_L(0); PG8_MMA(0, 0, At, B0); PG8_BAR; PG8_SCHED;
            PG8_LDB(B1, 0, 1); PG8_STAGE(PG8_SB(0, 0), b2, voffB);
            PG8_BAR; PG8_WAIT_L(0); PG8_MMA(0, 1, At, B1); PG8_BAR;
            PG8_LDA(At, 0, 1); PG8_STAGE(PG8_SA(0, 0), a2, voffA);
            PG8_BAR; PG8_WAIT_L(0); PG8_MMA(1, 0, At, B0); PG8_BAR; PG8_SCHED;
            PG8_STAGE(PG8_SB(0, 1), b2 + hstep, voffB);
            PG8_WAIT_V(6); PG8_BAR; PG8_MMA(1, 1, At, B1); PG8_BAR;
            PG8_LDB(B0, 1, 0); PG8_SCHED; PG8_LDA(At, 1, 0); PG8_STAGE(PG8_SA(0, 1), a2 + hstep, voffA);
            PG8_WAIT_L(8); PG8_BAR; PG8_WAIT_L(0); PG8_MMA(0, 0, At, B0); PG8_BAR; PG8_SCHED;
            PG8_LDB(B1, 1, 1); PG8_STAGE(PG8_SB(1, 0), b3, voffB);
            PG8_BAR; PG8_WAIT_L(0); PG8_MMA(0, 1, At, B1); PG8_BAR;
            PG8_LDA(At, 1, 1); PG8_STAGE(PG8_SA(1, 0), a3, voffA);
            PG8_BAR; PG8_WAIT_L(0); PG8_MMA(1, 0, At, B0); PG8_BAR; PG8_SCHED;
            PG8_STAGE(PG8_SB(1, 1), b3 + hstep, voffB);
            PG8_WAIT_V(6); PG8_BAR; PG8_MMA(1, 1, At, B1); PG8_BAR;
            }
        }
        if constexpr (ALIGN_EPI) { if (wr == 0) PG8_BAR; }
        if constexpr (!Epi::AFTER_DRAIN) { E(acc, cur, wr, wc, fr, fq); S.done(cur); }
        if (!has_next) break;
#pragma unroll
        for (int a = 0; a < 2; ++a)
#pragma unroll
            for (int b = 0; b < 2; ++b)
#pragma unroll
                for (int m = 0; m < 4; ++m)
#pragma unroll
                    for (int n = 0; n < 2; ++n) acc[a][b][m][n] = (f32x4){0.f, 0.f, 0.f, 0.f};
        cur = nxt; cA = nA; cB = nB; ++ui;
        if constexpr (ALIGN_EPI) { if (wr == 1) PG8_BAR; }
    }
    PG8_WAIT_V(0);
    if constexpr (!ALIGN_EPI) { if (wr == 0) PG8_BAR; }
    PG8_BAR;
    if constexpr (Epi::AFTER_DRAIN) { E.fused(acc, cur, wr, wc, fr, fq, lds, wid, lane); S.done(cur); }
#undef PG8_SA
#undef PG8_SB
#undef PG8_STAGE
#undef PG8_LDA
#undef PG8_LDB
#undef PG8_MMA
#undef PG8_WAIT_V
#undef PG8_WAIT_L
#undef PG8_BAR
#undef PG8_SCHED
}
}

#ifndef PG8_SP2
#define PG8_SP2 true
#endif
#ifndef PG8_ALIGN
#define PG8_ALIGN true
#endif
#include <hip/hip_bf16.h>
#include <cmath>
namespace attn_body {
using bf16=__hip_bfloat16;
using bf16x8=__attribute__((ext_vector_type(8)))short;
using s16x4=__attribute__((ext_vector_type(4)))short;
using f32x16=__attribute__((ext_vector_type(16)))float;
using f32x4=__attribute__((ext_vector_type(4)))float;
using u32x4=__attribute__((ext_vector_type(4)))unsigned;
using u32x2=__attribute__((ext_vector_type(2)))unsigned;
constexpr int BATCH=16,NHEAD=8,SEQ=2048,D=64,DM=NHEAD*D;
constexpr int OPITCH=1024;
constexpr int NW=8,QBLK=32,QB=QBLK*NW,KVBLK=64,NQB=SEQ/QB;
constexpr int ATTN_PITCH=DM, ATTN_UNIT_ROWS=QB;
constexpr float RMS_EPS=1e-6f;
__device__ __forceinline__ int crow(int r,int hi){return (r&3)+8*(r>>2)+4*hi;}
#define SBAR() __builtin_amdgcn_sched_barrier(0)
__device__ __forceinline__ void cmask(f32x16&p0,f32x16&p1,int jb,int qrel,int hi){
  const float NEG=-INFINITY; int kb=64*jb+4*hi;
  #pragma unroll
  for(int r=0;r<16;++r){int kv=kb+(r&3)+8*(r>>2); if(kv>qrel)p0[r]=NEG; if(kv+32>qrel)p1[r]=NEG;}
}

constexpr int NSLOT=3, SLOTB=8192;
constexpr int LDS_K=0, LDS_V=NSLOT*SLOTB, LDS_WS=2*NSLOT*SLOTB, LDS_OST=LDS_WS+NW*64*4, LDS_XK=LDS_OST+NW*4096+2048, LDS_ONES=LDS_XK+SEQ*8, LDS_BYTES=LDS_ONES+512;
constexpr float LOG2E=1.4426950408889634f;
constexpr float C2=0.125f*LOG2E;
__device__ __forceinline__ void glds16(const void*gsrc,unsigned lds_dst){unsigned keep;
  asm volatile("s_mov_b32 %0, m0\n\ts_mov_b32 m0, %2\n\ts_nop 0\n\tglobal_load_lds_dwordx4 %1, off\n\ts_mov_b32 m0, %0":"=&s"(keep):"v"(gsrc),"s"(lds_dst):"memory");}
__device__ __forceinline__ float max3f(float a,float b,float c){float r;asm("v_max3_f32 %0, %1, %2, %3":"=v"(r):"v"(a),"v"(b),"v"(c));return r;}
__device__ __forceinline__ float max2f(float a,float b){float r;asm("v_max_f32_e32 %0, %1, %2":"=v"(r):"v"(a),"v"(b));return r;}
__device__ __forceinline__ float fadd_s(float a,float b){float r;asm("v_add_f32_e32 %0, %1, %2":"=v"(r):"v"(a),"v"(b));return r;}
__device__ __forceinline__ float fsub_s(float a,float b){float r;asm("v_sub_f32_e32 %0, %1, %2":"=v"(r):"v"(a),"v"(b));return r;}
typedef float f32x2_t __attribute__((ext_vector_type(2))); typedef __bf16 bf16x2_t __attribute__((ext_vector_type(2)));
__device__ __forceinline__ unsigned cvtpk_s(float lo,float hi){f32x2_t v={lo,hi};bf16x2_t b=__builtin_convertvector(v,bf16x2_t);return __builtin_bit_cast(unsigned,b);}
#define WAIT_BAR(N) asm volatile("s_waitcnt vmcnt(" #N ") lgkmcnt(0)\n\ts_barrier":::"memory")
__device__ __forceinline__ unsigned bf16_rn(float f){unsigned u=__float_as_uint(f);return (u+0x7fffu+((u>>16)&1u))>>16;}
__device__ __forceinline__ void split3(float x,unsigned&a,unsigned&b,unsigned&c){a=bf16_rn(x);float r=x-__uint_as_float(a<<16);b=bf16_rn(r);r-=__uint_as_float(b<<16);c=bf16_rn(r);}
__device__ __forceinline__ float beta_at(const float*__restrict__ LPRE,const float*__restrict__ CHT,int b,int h,int pos){
  float carry=0.f; const int ck=pos>>7; for(int j=0;j<ck;++j)carry+=CHT[(b*(SEQ/128)+j)*NHEAD+h];
  return -(LPRE[((long)b*SEQ+pos)*NHEAD+h]+carry)*LOG2E; }
typedef __attribute__((address_space(3))) const char* lds_cptr;
typedef short v4i16_t __attribute__((ext_vector_type(4)));
#define KXF(v) __builtin_bit_cast(bf16x8,(u32x4){(v)[0],(v)[1],0u,0u})
__device__ __forceinline__ u32x2 kxload(lds_cptr p){ return *(const __attribute__((address_space(3))) u32x2*)p; }

__device__ __forceinline__ void qkt(f32x16&p0,f32x16&p1,const char*Kslot,const bf16x8*qr,int r32,int hi,lds_cptr kxp){
  const char*kb=Kslot+hi*1024+r32*16;
  { const u32x2 x0=kxload(kxp),x1=kxload(kxp+256);
    p0=__builtin_amdgcn_mfma_f32_32x32x16_bf16(KXF(x0),qr[4],f32x16{},0,0,0);p1=__builtin_amdgcn_mfma_f32_32x32x16_bf16(KXF(x1),qr[4],f32x16{},0,0,0); }
  #pragma unroll
  for(int d0=0;d0<4;++d0){
    const bf16x8 b0=*reinterpret_cast<const bf16x8*>(kb+d0*2048);
    const bf16x8 b1=*reinterpret_cast<const bf16x8*>(kb+d0*2048+512);
    p0=__builtin_amdgcn_mfma_f32_32x32x16_bf16(b0,qr[d0],p0,0,0,0);p1=__builtin_amdgcn_mfma_f32_32x32x16_bf16(b1,qr[d0],p1,0,0,0);}
}
__device__ __forceinline__ void kload8(bf16x8*kf,lds_cptr kp){
  kf[0]=*(const __attribute__((address_space(3))) bf16x8*)(kp);      kf[1]=*(const __attribute__((address_space(3))) bf16x8*)(kp+512);
  kf[2]=*(const __attribute__((address_space(3))) bf16x8*)(kp+2048); kf[3]=*(const __attribute__((address_space(3))) bf16x8*)(kp+2560);
  kf[4]=*(const __attribute__((address_space(3))) bf16x8*)(kp+4096); kf[5]=*(const __attribute__((address_space(3))) bf16x8*)(kp+4608);
  kf[6]=*(const __attribute__((address_space(3))) bf16x8*)(kp+6144); kf[7]=*(const __attribute__((address_space(3))) bf16x8*)(kp+6656);
}
__device__ __forceinline__ void kload2(bf16x8*kf,lds_cptr kp,int j){ kf[2*j]=*(const __attribute__((address_space(3))) bf16x8*)(kp+j*2048); kf[2*j+1]=*(const __attribute__((address_space(3))) bf16x8*)(kp+j*2048+512); }
__device__ __forceinline__ s16x4 vtr(lds_cptr p){ return __builtin_bit_cast(s16x4,__builtin_amdgcn_ds_read_tr16_b64_v4i16((__attribute__((address_space(3))) v4i16_t*)p)); }
__device__ __forceinline__ float rowmax(const f32x16&p0,const f32x16&p1){
  float a=max3f(p0[0],p0[1],p1[0]),b=max3f(p0[2],p0[3],p1[1]);a=max3f(a,p1[2],p1[3]);
  #pragma unroll
  for(int r=4;r<16;r+=4){a=max3f(a,p0[r],p0[r+1]);b=max3f(b,p0[r+2],p0[r+3]);a=max3f(a,p1[r],p1[r+1]);b=max3f(b,p1[r+2],p1[r+3]);}
  const float m=max2f(a,b);
  auto rr=__builtin_amdgcn_permlane32_swap(__float_as_uint(m),__float_as_uint(m),false,false);
  return max2f(__uint_as_float(rr[0]),__uint_as_float(rr[1]));
}
__device__ __forceinline__ void pv(f32x16*o,int vb,bf16x8 pa0,bf16x8 pa1,bf16x8 pa2,bf16x8 pa3){
  #pragma unroll
  for(int d0=0;d0<2;++d0){s16x4 lo[4],hi[4];
    #pragma unroll
    for(int ks=0;ks<4;++ks){
      asm volatile("ds_read_b64_tr_b16 %0,%1 offset:%c2":"=&v"(lo[ks]):"v"(vb),"i"(d0*4096+ks*1024):"memory");
      asm volatile("ds_read_b64_tr_b16 %0,%1 offset:%c2":"=&v"(hi[ks]):"v"(vb),"i"(d0*4096+ks*1024+512):"memory");}
    asm volatile("s_waitcnt lgkmcnt(0)":::"memory");SBAR();
    #define PK(k) (bf16x8){lo[k][0],lo[k][1],lo[k][2],lo[k][3],hi[k][0],hi[k][1],hi[k][2],hi[k][3]}
    o[d0]=__builtin_amdgcn_mfma_f32_32x32x16_bf16(pa0,PK(0),o[d0],0,0,0);
    o[d0]=__builtin_amdgcn_mfma_f32_32x32x16_bf16(pa1,PK(1),o[d0],0,0,0);
    o[d0]=__builtin_amdgcn_mfma_f32_32x32x16_bf16(pa2,PK(2),o[d0],0,0,0);
    o[d0]=__builtin_amdgcn_mfma_f32_32x32x16_bf16(pa3,PK(3),o[d0],0,0,0);
    #undef PK
  }
}

#ifndef ATTN_STORE16
#define ATTN_STORE16(p,v) (*(u32x4*)(p)=(v))
#endif
struct AttnTensors { const bf16* Q; const bf16* K; const bf16* V; bf16* O; const float* LPRE; const float* CHT; const float* GO; };
template<int THRL> __device__ __forceinline__ void attn_unit(int b,int h,int qb,const AttnTensors&T,char*shm){
  const bf16*Q=T.Q; const bf16*__restrict__ K=T.K; const bf16*__restrict__ V=T.V; bf16*O=T.O;
  const int tid=threadIdx.x,lane=tid&63,r32=lane&31,hi=lane>>5; const int wid=__builtin_amdgcn_readfirstlane(tid>>6);
  const long rowbase=(long)b*SEQ; const int q0=qb*QB;
  const bf16*Qw=Q+(rowbase+q0+wid*QBLK)*DM+h*D;
  const bf16*Kh=K+rowbase*DM+h*D,*Vh=V+rowbase*DM+h*D;
  const unsigned lds0=(unsigned)(uintptr_t)shm;
  float*wsf=(float*)(shm+LDS_WS)+wid*64;
  const bf16*ksrc=Kh+(long)lane*DM+wid*8;
  const bf16*vsrc=Vh+(long)(16*(wid&3)+(lane>>2))*DM+(wid>>2)*32+(lane&3)*8;
  const unsigned kdst=lds0+LDS_K+wid*1024, vdst=lds0+LDS_V+wid*1024;
  #define DMA_K(t,slot) glds16(ksrc+(long)(t)*KVBLK*DM,(unsigned)__builtin_amdgcn_readfirstlane(kdst+(slot)))
  #define DMA_V(t,slot) glds16(vsrc+(long)(t)*KVBLK*DM,(unsigned)__builtin_amdgcn_readfirstlane(vdst+(slot)))
  const int vb0=(int)(lds0+LDS_V)+((lane>>4)&1)*32+(lane&3)*8+(4*hi+((lane&15)>>2))*64;
  const char*Kbase=shm+LDS_K; bf16x8 kf[8];
  const lds_cptr shm3=(lds_cptr)shm; const lds_cptr kp0=shm3+LDS_K+hi*1024+r32*16; const lds_cptr vp0=shm3+LDS_V+((lane>>4)&1)*32+(lane&3)*8+(4*hi+((lane&15)>>2))*64;
  const int NT=(q0+QB)/KVBLK;
  DMA_K(0,0);DMA_V(0,0);DMA_K(1,SLOTB);
  float cht[SEQ/128];
  #pragma unroll
  for(int j=0;j<SEQ/128;++j)cht[j]=T.CHT[(b*(SEQ/128)+j)*NHEAD+h];
  { int tidv=tid; asm volatile("":"+v"(tidv));
    const int s0=4*tidv;
    if(s0<q0+QB){ float carry=0.f; const int ck=s0>>7;
      #pragma unroll
      for(int j=0;j<SEQ/128;++j)carry+=(j<ck)?cht[j]:0.f;
      #pragma unroll
      for(int i=0;i<4;++i){ const float beta=-(T.LPRE[(rowbase+s0+i)*NHEAD+h]+carry)*LOG2E; unsigned a,bb,c; split3(beta,a,bb,c);
        *(__attribute__((address_space(3))) u32x2*)(shm3+LDS_XK+(s0+i)*8)=(u32x2){a|(bb<<16),c|0x3F800000u}; } }
    if(tidv<64)*(__attribute__((address_space(3))) u32x2*)(shm3+LDS_ONES+tidv*8)=(u32x2){0x3F803F80u,0x3F803F80u}; }
  bf16x8 qr[5]; u32x4 q4;
  #pragma unroll
  for(int d0=0;d0<4;++d0)qr[d0]=*reinterpret_cast<const bf16x8*>(&Qw[(long)r32*DM+d0*16+hi*8]);
  { const int qpos=q0+wid*QBLK+r32,ckq=qpos>>7; float carry=0.f;
    #pragma unroll
    for(int j=0;j<SEQ/128;++j)carry+=(j<ckq)?cht[j]:0.f;
    const float bq=-(T.LPRE[(rowbase+qpos)*NHEAD+h]+carry)*LOG2E; unsigned a,bb,c; split3(-bq,a,bb,c);
    q4=hi?(u32x4){a|(bb<<16),c,0u,0u}:(u32x4){0x3F803F80u,0x00003F80u,0u,0u}; }
  const lds_cptr kxb=hi?(shm3+LDS_ONES+r32*8):(shm3+LDS_XK+r32*8); const int kxs=hi?0:512;
  float mhat=0.f,l_reg=0.f;f32x16 o[2];o[0]=f32x16{};o[1]=f32x16{};
  #define SETM() do{ unsigned a_=bf16_rn(-mhat); const float lo_=-mhat-__uint_as_float(a_<<16); const unsigned b_=bf16_rn(lo_); q4[1]=(q4[1]&0xffffu)|((hi?b_:a_)<<16); qr[4]=__builtin_bit_cast(bf16x8,q4); }while(0)
  SETM();
  const int qrel=wid*QBLK+r32;
  #define CMASK(P0,P1,t) do{int jb_=(t)-(NT-4); if(jb_>=0)cmask(P0,P1,jb_,qrel,hi);}while(0)
  bool resc=false;
  #define START(P0,P1) do{ const float rm=rowmax(P0,P1); resc=false; \
    { const float dl=__builtin_fmaxf(__builtin_ceilf(rm),0.f); mhat=fadd_s(mhat,dl);     \
      _Pragma("unroll") for(int r=0;r<16;++r){P0[r]=fsub_s(P0[r],dl);P1[r]=fsub_s(P1[r],dl);} \
      SETM(); } \
    _Pragma("unroll") for(int r=0;r<16;++r)P0[r]=__builtin_amdgcn_exp2f(P0[r]); }while(0)
  #define RESC() do{ if(resc){ asm volatile("s_waitcnt lgkmcnt(0)":::"memory"); \
      _Pragma("unroll") for(int d_=0;d_<2;++d_) _Pragma("unroll") for(int r=0;r<16;++r)o[d_][r]*=wsf[crow(r,hi)]; } }while(0)
  f32x16 pA0,pA1,pB0,pB1;
  int sl_prev=0,sl_cur=0,sl_next=SLOTB;
  #define ROT() do{sl_prev=sl_cur;sl_cur=sl_next;sl_next=(sl_next==(NSLOT-1)*SLOTB)?0:sl_next+SLOTB;}while(0)
  DMA_K(2,2*SLOTB);
  WAIT_BAR(3);
  qkt(pA0,pA1,Kbase,qr,r32,hi,kxb);asm volatile("s_nop 15\n\ts_nop 7":"+v"(pA0),"+v"(pA1));CMASK(pA0,pA1,0);
  START(pA0,pA1);
  _Pragma("unroll") for(int r=0;r<16;++r)pA1[r]=__builtin_amdgcn_exp2f(pA1[r]);
  WAIT_BAR(0);
  DMA_K(3,0);DMA_V(1,SLOTB);
  ROT();
  kload8(kf,kp0+sl_cur);
  WAIT_BAR(2);
  s16x4 vlo[8],vhi[8]; u32x4 pw0,pw1,pw2,pw3;
  #define PKW(P,B) cvtpk_s(P[B],P[B+1])
  #define PAF(k) __builtin_bit_cast(bf16x8,pw##k)
  #define VFR(i) (bf16x8){vlo[i][0],vlo[i][1],vlo[i][2],vlo[i][3],vhi[i][0],vhi[i][1],vhi[i][2],vhi[i][3]}
  #define PIN(x) asm volatile("":"+v"(x))
  #define MX3(a,b,c) __builtin_fmaxf(__builtin_fmaxf((a),(b)),(c))
  #define GAPA(MF,A0,A1,A2,A3,W0,W1,PW) do{ MF; sacc+=A0; sacc+=A1; sacc+=A2; sacc+=A3; PIN(sacc); W0; W1; PIN(PW); SBAR(); }while(0)
  #define EX(v) __builtin_amdgcn_exp2f(v)
  #define GAPB(MF,X,B) do{ MF; X[B]=EX(X[B]); X[B+1]=EX(X[B+1]); X[B+2]=EX(X[B+2]); X[B+3]=EX(X[B+3]); PIN(X); SBAR(); }while(0)
  #define VRD(i) do{ vlo[i]=vtr(vp_+(((i)>>2)*4096+((i)&3)*1024)); vhi[i]=vtr(vp_+(((i)>>2)*4096+((i)&3)*1024+512)); }while(0)
  #define KRD(G,j) do{ if(G){ kload2(kf,kp0+sl_next,j); SBAR(); } }while(0)
  #define STEP(C0,C1,P0,P1,t,GK,GV,GL) do{ SBAR(); \
    const lds_cptr vp_=vp0+sl_prev; const lds_cptr kxp_=kxb+(t)*kxs; \
    const u32x2 kx0_=kxload(kxp_),kx1_=kxload(kxp_+256); SBAR(); \
    VRD(0); SBAR(); float sacc=(P0[0]+P0[1]); \
    C0=__builtin_amdgcn_mfma_f32_32x32x16_bf16(KXF(kx0_),qr[4],f32x16{},0,0,0); C1=__builtin_amdgcn_mfma_f32_32x32x16_bf16(KXF(kx1_),qr[4],f32x16{},0,0,0); SBAR(); \
    GAPA(C0=__builtin_amdgcn_mfma_f32_32x32x16_bf16(kf[0],qr[0],C0,0,0,0), P0[2],P0[3],P0[4],P0[5],     pw0[0]=PKW(P0,0), pw0[1]=PKW(P0,2), pw0); \
    VRD(4); SBAR(); GAPA(C1=__builtin_amdgcn_mfma_f32_32x32x16_bf16(kf[1],qr[0],C1,0,0,0), P0[6],P0[7],P0[8],P0[9],     pw0[2]=PKW(P0,4), pw0[3]=PKW(P0,6), pw0); \
    VRD(1); SBAR(); GAPA(C0=__builtin_amdgcn_mfma_f32_32x32x16_bf16(kf[2],qr[1],C0,0,0,0),   P0[10],P0[11],P0[12],P0[13], pw1[0]=PKW(P0,8), pw1[1]=PKW(P0,10), pw1); \
    VRD(5); SBAR(); GAPA(C1=__builtin_amdgcn_mfma_f32_32x32x16_bf16(kf[3],qr[1],C1,0,0,0),   P0[14],P0[15],P1[0],P1[1],   pw1[2]=PKW(P0,12),pw1[3]=PKW(P0,14), pw1); \
    VRD(2); SBAR(); GAPA(C0=__builtin_amdgcn_mfma_f32_32x32x16_bf16(kf[4],qr[2],C0,0,0,0),   P1[2],P1[3],P1[4],P1[5],     pw2[0]=PKW(P1,0), pw2[1]=PKW(P1,2), pw2); \
    VRD(6); SBAR(); GAPA(C1=__builtin_amdgcn_mfma_f32_32x32x16_bf16(kf[5],qr[2],C1,0,0,0),   P1[6],P1[7],P1[8],P1[9],     pw2[2]=PKW(P1,4), pw2[3]=PKW(P1,6), pw2); \
    VRD(3); SBAR(); GAPA(C0=__builtin_amdgcn_mfma_f32_32x32x16_bf16(kf[6],qr[3],C0,0,0,0),   P1[10],P1[11],P1[12],P1[13], pw3[0]=PKW(P1,8), pw3[1]=PKW(P1,10), pw3); \
    VRD(7); SBAR(); GAPA(C1=__builtin_amdgcn_mfma_f32_32x32x16_bf16(kf[7],qr[3],C1,0,0,0),   P1[14],P1[15],0.f,0.f,       pw3[2]=PKW(P1,12),pw3[3]=PKW(P1,14), pw3); \
    l_reg+=sacc; \
    if(GK){DMA_K((t)+3,sl_cur);} if(GV){DMA_V((t)+1,sl_next);} \
    CMASK(C0,C1,t); \
    { float a=MX3(C0[0],C0[1],C1[0]),b=MX3(C0[2],C0[3],C1[1]); a=MX3(a,C1[2],C1[3]); \
      _Pragma("unroll") for(int r=4;r<16;r+=4){a=MX3(a,C0[r],C0[r+1]);b=MX3(b,C0[r+2],C0[r+3]);a=MX3(a,C1[r],C1[r+1]);b=MX3(b,C1[r+2],C1[r+3]);} \
      float rm=__builtin_fmaxf(a,b); { auto rr=__builtin_amdgcn_permlane32_swap(__float_as_uint(rm),__float_as_uint(rm),false,false); rm=__builtin_fmaxf(__uint_as_float(rr[0]),__uint_as_float(rr[1])); } \
      resc=false; \
      if(__builtin_expect(__any(rm>(float)THRL),0)){ const float dl=__builtin_ceilf(__builtin_fmaxf(rm,0.f)); mhat+=dl; \
        _Pragma("unroll") for(int r=0;r<16;++r){C0[r]-=dl;C1[r]-=dl;} \
        SETM(); \
        const float f=__builtin_amdgcn_exp2f(-dl); l_reg*=f; if(hi==0)wsf[r32]=f; resc=true; } } \
    SBAR(); \
    GAPB(o[0]=__builtin_amdgcn_mfma_f32_32x32x16_bf16(PAF(0),VFR(0),o[0],0,0,0), C0,0); \
    GAPB(o[1]=__builtin_amdgcn_mfma_f32_32x32x16_bf16(PAF(0),VFR(4),o[1],0,0,0), C0,4); \
    KRD(GL,0); GAPB(o[0]=__builtin_amdgcn_mfma_f32_32x32x16_bf16(PAF(1),VFR(1),o[0],0,0,0), C0,8); \
    KRD(GL,1); GAPB(o[1]=__builtin_amdgcn_mfma_f32_32x32x16_bf16(PAF(1),VFR(5),o[1],0,0,0), C0,12); \
    KRD(GL,2); GAPB(o[0]=__builtin_amdgcn_mfma_f32_32x32x16_bf16(PAF(2),VFR(2),o[0],0,0,0), C1,0); \
    KRD(GL,3); GAPB(o[1]=__builtin_amdgcn_mfma_f32_32x32x16_bf16(PAF(2),VFR(6),o[1],0,0,0), C1,4); \
    GAPB(o[0]=__builtin_amdgcn_mfma_f32_32x32x16_bf16(PAF(3),VFR(3),o[0],0,0,0), C1,8); \
    GAPB(o[1]=__builtin_amdgcn_mfma_f32_32x32x16_bf16(PAF(3),VFR(7),o[1],0,0,0), C1,12); \
    }while(0)
  int t=1;
  #undef CMASK
  #define CMASK(P0,P1,t) do{}while(0)
  for(;t+5<NT;t+=2){
    STEP(pB0,pB1,pA0,pA1,t,true,true,true);     WAIT_BAR(2); RESC(); ROT();
    STEP(pA0,pA1,pB0,pB1,t+1,true,true,true);   WAIT_BAR(2); RESC(); ROT();
  }
  #undef CMASK
  #define CMASK(P0,P1,t) do{int jb_=(t)-(NT-4); if(jb_>=0)cmask(P0,P1,jb_,qrel,hi);}while(0)
  #define ENDW(tt) do{ if((tt)+3<NT){WAIT_BAR(2);} else if((tt)+2<NT){WAIT_BAR(1);} else {WAIT_BAR(0);} }while(0)
  for(;t+1<NT;t+=2){
    STEP(pB0,pB1,pA0,pA1,t,(t+3<NT),(t+1<NT),(t+1<NT));       ENDW(t);   RESC(); ROT();
    STEP(pA0,pA1,pB0,pB1,t+1,(t+4<NT),(t+2<NT),(t+2<NT));     ENDW(t+1); RESC(); ROT();
  }
  STEP(pB0,pB1,pA0,pA1,NT-1,false,false,false); RESC();
  { float sacc=pB0[0]+pB0[1]; _Pragma("unroll") for(int r=2;r<16;++r)sacc+=pB0[r]; _Pragma("unroll") for(int r=0;r<16;++r)sacc+=pB1[r]; l_reg+=sacc;
    pw0=(u32x4){PKW(pB0,0),PKW(pB0,2),PKW(pB0,4),PKW(pB0,6)};pw1=(u32x4){PKW(pB0,8),PKW(pB0,10),PKW(pB0,12),PKW(pB0,14)};pw2=(u32x4){PKW(pB1,0),PKW(pB1,2),PKW(pB1,4),PKW(pB1,6)};pw3=(u32x4){PKW(pB1,8),PKW(pB1,10),PKW(pB1,12),PKW(pB1,14)};
    SBAR(); pv(o,vb0+sl_cur,PAF(0),PAF(1),PAF(2),PAF(3)); }
  #undef PKW
  #undef PAF
  #undef VFR
  #undef PIN
  #undef MX3
  #undef GAPA
  #undef GAPB
  #undef EX
  #undef VRD
  #undef KRD
  #undef STEP
  #undef ENDW
  {auto rr=__builtin_amdgcn_permlane32_swap(__float_as_uint(l_reg),__float_as_uint(l_reg),false,false);l_reg=__uint_as_float(rr[0])+__uint_as_float(rr[1]);}
  if(hi==0)wsf[32+r32]=l_reg;asm volatile("s_waitcnt lgkmcnt(0)":::"memory");
  float rli[16];
  #pragma unroll
  for(int r=0;r<16;++r)rli[r]=__builtin_amdgcn_rcpf(wsf[32+crow(r,hi)]);
  bf16*Ow=O+(rowbase+q0+wid*QBLK)*OPITCH+h*D;
  { float*stg=(float*)(shm+LDS_OST)+wid*1024;
    int lane_e=lane; asm volatile("":"+v"(lane_e));
    const int srow=lane_e>>2,sc16=(lane_e&3)*16;
    f32x4 gq[4];
    #pragma unroll
    for(int j=0;j<4;++j)gq[j]=*(const f32x4*)(T.GO+h*D+sc16+4*j);
    #pragma unroll
    for(int p=0;p<2;++p){
      #pragma unroll
      for(int rr=0;rr<8;++rr){ const int r=8*p+rr, orow=(rr&3)+8*(rr>>2)+4*hi;
        #pragma unroll
        for(int d0=0;d0<2;++d0)stg[orow*64+d0*32+r32]=o[d0][r]*rli[r]; }
      asm volatile("s_waitcnt lgkmcnt(0)":::"memory");
      f32x4 v[4]; float ss=0.f;
      #pragma unroll
      for(int j=0;j<4;++j){ v[j]=*(const f32x4*)(stg+srow*64+sc16+4*j); ss+=(v[j][0]*v[j][0]+v[j][1]*v[j][1])+(v[j][2]*v[j][2]+v[j][3]*v[j][3]); }
      asm volatile("s_waitcnt lgkmcnt(0)":::"memory");
      ss+=__shfl_xor(ss,1); ss+=__shfl_xor(ss,2);
      const float rs=1.0f/sqrtf(ss*(1.0f/64.0f)+RMS_EPS);
      u32x4 w0,w1;
      #pragma unroll
      for(int j=0;j<4;++j)v[j]=v[j]*rs*gq[j];
      w0[0]=cvtpk_s(v[0][0],v[0][1]);w0[1]=cvtpk_s(v[0][2],v[0][3]);w0[2]=cvtpk_s(v[1][0],v[1][1]);w0[3]=cvtpk_s(v[1][2],v[1][3]);
      w1[0]=cvtpk_s(v[2][0],v[2][1]);w1[1]=cvtpk_s(v[2][2],v[2][3]);w1[2]=cvtpk_s(v[3][0],v[3][1]);w1[3]=cvtpk_s(v[3][2],v[3][3]);
      bf16*op=Ow+(long)(16*p+srow)*OPITCH+sc16; ATTN_STORE16(op,w0); ATTN_STORE16(op+8,w1);
    } }
  asm volatile("s_waitcnt lgkmcnt(0)\n\ts_barrier":::"memory");
  #undef DMA_K
  #undef DMA_V
  #undef CMASK
  #undef START
  #undef RESC
  #undef ROT
  #undef SETM
}
constexpr int ATTN_LDS_BYTES=LDS_BYTES;
struct AttnUnit { int bh; int qb; };
struct StaticOrder {
  int vcu, G;
  __device__ __forceinline__ explicit StaticOrder(int grid,int vcu_):vcu(vcu_),G(grid){}
  __device__ __forceinline__ bool next(int i,AttnUnit&u)const{
    if(G==256){ if(i>=4)return false; const int s=vcu&1; u.bh=vcu>>1; u.qb=(i==0)?7-s:(i==1)?4+s:(i==2)?3-s:s; return true; }
    const int idx=i*G+vcu; if(idx>=BATCH*NHEAD*NQB)return false; u.bh=idx/NQB; u.qb=NQB-1-(idx%NQB); return true; }
};
template<int THRL=8> __device__ __forceinline__ void attn_phase(char*lds,const AttnTensors&T,const StaticOrder&S,int reps){
  AttnUnit u;
  for(int rep=0;rep<reps;++rep)
  for(int i=0;S.next(i,u);++i){ attn_unit<THRL>(u.bh/NHEAD,u.bh%NHEAD,u.qb,T,lds); }
}
#undef SBAR
#undef WAIT_BAR
#undef KXF
}
constexpr int NWAVES = 8;
#ifndef MK_N_LAUNCHES
#define MK_N_LAUNCHES 1
#endif
constexpr int N_LAUNCHES = MK_N_LAUNCHES;
constexpr int PER_PHASE = 8;
constexpr int N_BAR_REGIONS = 1;

constexpr int BATCH = 16, T = 2048, D = 1024, H = 8, HD = 64, AW = 512, CW = 512, FF = 4096, CK = 31;
constexpr int M = BATCH * T;
constexpr int IN_COLS = 3 * AW + 2 * CW + H;
constexpr int NPROJ = 2560;
constexpr float EPS = 1e-6f;

constexpr size_t MiB = 1u << 20;
constexpr size_t WS_CTL = 0, CTL_ZERO_BYTES = 1 * MiB;
constexpr size_t WS_WIN = 2 * MiB, WS_WPW = 7 * MiB, WS_WOUT = 8 * MiB, WS_WUP = 10 * MiB, WS_WDN = 18 * MiB;
constexpr size_t WS_LPRE = 26 * MiB;
constexpr size_t WS_CHT = 27 * MiB;
constexpr size_t WS_SSQ1 = 28 * MiB, WS_SSQ2 = 28 * MiB + 512 * 1024;
constexpr size_t WS_XN = 32 * MiB;
constexpr size_t WS_Q = 96 * MiB, WS_K = 128 * MiB, WS_V = 160 * MiB;
constexpr size_t WS_U = 192 * MiB;
constexpr size_t WS_UC = 224 * MiB;
constexpr size_t WS_CAT = 256 * MiB;
constexpr size_t WS_H = 96 * MiB;
constexpr size_t WS_END = 352 * MiB;
static_assert(WS_CAT + (size_t)M * 1024 * 2 <= WS_END && WS_H + (size_t)M * FF * 2 <= WS_END && WS_XN + (size_t)M * D * 2 <= WS_Q && WS_WDN + (size_t)D * FF * 2 <= WS_LPRE, "d_ws map");
constexpr int CW_TMO = 0, CW_CODE = 1;
constexpr int CW_BAR = 4096;

constexpr int RING_OFF = 0, RING_BYTES = 131072;
constexpr int LDSCTL_OFF = RING_BYTES, MISC_OFF = LDSCTL_OFF + 320;
constexpr int SCR_OFF = RING_BYTES + 1024;
constexpr int LDS_BYTES = 147456;
static_assert(MISC_OFF + 128 <= SCR_OFF && SCR_OFF + 4096 <= LDS_BYTES, "LDS map");
#define GAS __attribute__((address_space(1)))
#define LAS __attribute__((address_space(3)))
typedef unsigned short bf16;
typedef unsigned v4u __attribute__((ext_vector_type(4)));
typedef float f32x4 __attribute__((ext_vector_type(4)));
typedef short bf16x8 __attribute__((ext_vector_type(8)));
typedef GAS unsigned gu32;
typedef GAS unsigned long long gu64;
#define RLX_AGENT __ATOMIC_RELAXED, __HIP_MEMORY_SCOPE_AGENT
#define LDS_WAIT() asm volatile("s_waitcnt lgkmcnt(0)" ::: "memory")
#define VM_WAIT() asm volatile("s_waitcnt vmcnt(0)" ::: "memory")
__device__ __forceinline__ unsigned long long rt() { return __builtin_amdgcn_s_memrealtime(); }
__device__ __forceinline__ unsigned f2bf(float f) { unsigned u = __builtin_bit_cast(unsigned, f); return (u + 0x7fffu + ((u >> 16) & 1u)) >> 16; }
__device__ __forceinline__ unsigned pk2(float lo, float hi) { return f2bf(lo) | (f2bf(hi) << 16); }

#define XB_TMO      128
#define XB_XCNT(j)  (256  + 64 * (j))
#define XB_XSUB(j)  (1280 + 64 * (j))
#define XB_XGEN(j)  (2304 + 64 * (j))
#define XB_TOP      3328
#define XB_TOPGEN   3392
#define XCD_BAR_WORDS 3456
#define XB_SPIN_CAP (1u << 18)

__device__ __forceinline__ unsigned xb_ld(unsigned* p)              { return __hip_atomic_load(p, __ATOMIC_RELAXED, __HIP_MEMORY_SCOPE_AGENT); }
__device__ __forceinline__ unsigned xb_add(unsigned* p, unsigned v) { return __hip_atomic_fetch_add(p, v, __ATOMIC_RELAXED, __HIP_MEMORY_SCOPE_AGENT); }
__device__ __forceinline__ unsigned xb_xcc_id() { return (unsigned)__builtin_amdgcn_s_getreg((3 << 11) | 20) & 0xFu; }
#define XB_SPIN(cond, bar) do { unsigned _sp = 0; while (cond) { __builtin_amdgcn_s_sleep(1); \
    if ((++_sp & 255u) == 0u) { if (xb_ld(&(bar)[XB_TMO])) break; if (_sp > XB_SPIN_CAP) { atomicAdd(&(bar)[XB_TMO], 1u); break; } } } } while (0)

struct XcdBarrier {
    unsigned* bar; unsigned x;
    volatile LAS unsigned* st;
};

__device__ __forceinline__ XcdBarrier xcd_barrier_post(unsigned* bar, volatile LAS unsigned* st) {
    XcdBarrier b; b.bar = bar; b.x = xb_xcc_id(); b.st = st;
    if (threadIdx.x == 0) (void)xb_add(&bar[XB_XCNT(b.x)], 1u);
    return b;
}
__device__ __forceinline__ void xcd_barrier_complete(unsigned* bar, unsigned x, unsigned& nloc, unsigned& nx) {
    const unsigned G = gridDim.x * gridDim.y * gridDim.z;
    unsigned sum, cnt, mine, sp = 0u;
    for (;;) {
        sum = 0u; cnt = 0u; mine = 0u;
#pragma unroll
        for (unsigned j = 0; j < 16; ++j) { const unsigned c = xb_ld(&bar[XB_XCNT(j)]); sum += c; cnt += (c > 0u) ? 1u : 0u; mine = (j == x) ? c : mine; }
        if (sum == G) break;
        __builtin_amdgcn_s_sleep(1);
        if ((++sp & 255u) == 0u) { if (xb_ld(&bar[XB_TMO])) break; if (sp > XB_SPIN_CAP) { atomicAdd(&bar[XB_TMO], 1u); break; } }
    }
    nloc = mine > 0u ? mine : 1u; nx = cnt > 0u ? cnt : 1u;
}

__device__ __forceinline__ void xcd_barrier(const XcdBarrier& b) {
    asm volatile("s_waitcnt vmcnt(0)" ::: "memory");
    __syncthreads();
    if (threadIdx.x == 0) {
        unsigned* bar = b.bar;
        __builtin_amdgcn_s_waitcnt(0);
        unsigned nloc = b.st[0], nx = b.st[1];
        if (nloc == 0u) { xcd_barrier_complete(bar, b.x, nloc, nx); b.st[0] = nloc; b.st[1] = nx; }
        const unsigned old = xb_add(&bar[XB_XSUB(b.x)], 1u);
        const unsigned gen = old / nloc;
        if (old + 1u == (gen + 1u) * nloc) {
            __builtin_amdgcn_fence(__ATOMIC_RELEASE, "agent");
            asm volatile("s_waitcnt vmcnt(0)" ::: "memory");
            const unsigned og = xb_add(&bar[XB_TOP], 1u);
            const unsigned tg = og / nx;
            if (og + 1u == (tg + 1u) * nx) xb_add(&bar[XB_TOPGEN], 1u);
            else XB_SPIN(xb_ld(&bar[XB_TOPGEN]) == tg, bar);
            __builtin_amdgcn_fence(__ATOMIC_ACQUIRE, "agent");
            xb_add(&bar[XB_XGEN(b.x)], 1u);
            asm volatile("s_waitcnt vmcnt(0)" ::: "memory");
        } else {
            XB_SPIN(xb_ld(&bar[XB_XGEN(b.x)]) == gen, bar);
            __builtin_amdgcn_fence(__ATOMIC_ACQUIRE, "agent");
            asm volatile("s_waitcnt vmcnt(0)" ::: "memory");
        }
    }
    __syncthreads();
}
struct Frame {
    LAS unsigned char* lds;
    volatile LAS unsigned* MISC;
    gu32* ctl;
    int tid, lane, wave;
    int vcu, G;
    const float* x; float* out;
    const float *norm_mix_g, *w_in, *b_forget, *conv_dw_w, *conv_dw_b, *conv_ln_g, *conv_ln_b, *w_conv_pw, *b_conv_pw, *attn_out_g, *conv_out_g, *w_out, *norm_ffn_g, *w_up, *w_dn, *norm_final_g;
    bf16 *WIN_t, *WPW_t, *WOUT_t, *WUP_t, *WDN_t;
    bf16 *XN, *QB, *KB, *VB, *UB, *UC, *CAT, *HB;
    float *LPRE, *CHT, *SSQ1, *SSQ2;
};

__device__ __forceinline__ float wave_sum(float v) {
#pragma unroll
    for (int o = 1; o < 64; o <<= 1) v += __shfl_xor(v, o);
    return v;
}
__device__ __forceinline__ void p0_transpose_item(const float* W, int ldw, int srcn0, int k0, const float* ks, bf16* WT, int K, int dstn0, LAS float* scr, int lane) {
#pragma unroll
    for (int i = 0; i < 32; ++i) { const int kk = 2 * i + (lane >> 5); float v = W[(size_t)(k0 + kk) * ldw + srcn0 + (lane & 31)]; if (ks) v *= ks[k0 + kk]; scr[kk * 33 + (lane & 31)] = v; }
    LDS_WAIT(); asm volatile("" ::: "memory");
    const int c = lane & 7;
#pragma unroll
    for (int j = 0; j < 4; ++j) { const int n = (lane >> 3) + 8 * j; const LAS float* s = scr + (8 * c) * 33 + n;
        v4u o; o.x = pk2(s[0 * 33], s[1 * 33]); o.y = pk2(s[2 * 33], s[3 * 33]); o.z = pk2(s[4 * 33], s[5 * 33]); o.w = pk2(s[6 * 33], s[7 * 33]);
        *(GAS v4u*)(WT + (size_t)(dstn0 + n) * K + k0 + 8 * c) = o; }
    LDS_WAIT(); asm volatile("" ::: "memory");
}
__device__ __forceinline__ int win_src_col(int n0) { if (n0 < 3 * AW) return n0; const int r = n0 - 3 * AW, j = r >> 8, w = r & 255; return (w < 128) ? (3 * AW + 128 * j + w) : (3 * AW + CW + 128 * j + (w - 128)); }
__device__ __forceinline__ float log_sigmoid_f(float x) { return fminf(x, 0.f) - log1pf(expf(-fabsf(x))); }

__device__ __forceinline__ void p0_prologue(Frame& F) {
    LAS float* scr = (LAS float*)(F.lds + RING_OFF + F.wave * 16384);
    const int gw = F.vcu * NWAVES + F.wave, NGW = F.G * NWAVES;
    constexpr int I_IN = (D / 64) * (NPROJ / 32), I_PW = (CW / 64) * (CW / 32), I_OUT = (D / 64) * (D / 32), I_UP = (D / 64) * (FF / 32), I_DN = (FF / 64) * (D / 32);
    constexpr int NITEMS = I_IN + I_PW + I_OUT + I_UP + I_DN;
    for (int it = gw; it < NITEMS; it += NGW) {
        int r = it;
        if (r < I_IN) { const int nb = NPROJ / 32, kb = r / nb, n0 = 32 * (r % nb); p0_transpose_item(F.w_in, IN_COLS, win_src_col(n0), 64 * kb, nullptr, F.WIN_t, D, n0, scr, F.lane); continue; } r -= I_IN;
        if (r < I_PW) { const int nb = CW / 32, kb = r / nb, n0 = 32 * (r % nb); p0_transpose_item(F.w_conv_pw, CW, n0, 64 * kb, nullptr, F.WPW_t, CW, n0, scr, F.lane); continue; } r -= I_PW;
        if (r < I_OUT) { const int nb = D / 32, kb = r / nb, n0 = 32 * (r % nb); p0_transpose_item(F.w_out, D, n0, 64 * kb, nullptr, F.WOUT_t, D, n0, scr, F.lane); continue; } r -= I_OUT;
        if (r < I_UP) { const int nb = FF / 32, kb = r / nb, n0 = 32 * (r % nb); p0_transpose_item(F.w_up, FF, n0, 64 * kb, F.norm_ffn_g, F.WUP_t, D, n0, scr, F.lane); continue; } r -= I_UP;
        { const int nb = D / 32, kb = r / nb, n0 = 32 * (r % nb); p0_transpose_item(F.w_dn, D, n0, 64 * kb, nullptr, F.WDN_t, FF, n0, scr, F.lane); }
    }
    __syncthreads();
    LAS float* SCAN = (LAS float*)(F.lds + RING_OFF);
    LAS float* WTOT = SCAN + 1024;
    f32x4 gv[4]; f32x4 wf[4][4][2];
#pragma unroll
    for (int j = 0; j < 4; ++j) { gv[j] = *(const GAS f32x4*)(F.norm_mix_g + 4 * F.lane + 256 * j);
#pragma unroll
        for (int i = 0; i < 4; ++i) { const float* wp = F.w_in + (size_t)(4 * F.lane + i + 256 * j) * IN_COLS + NPROJ; wf[j][i][0] = *(const GAS f32x4*)wp; wf[j][i][1] = *(const GAS f32x4*)(wp + 4); } }
    const int hsel = F.lane & 7; const float bfv = F.b_forget[hsel];
    for (int ck = F.vcu; ck < M / 128; ck += F.G) {
        float pref = 0.f;
        f32x4 vn[4];
        { const GAS f32x4* xr = (const GAS f32x4*)(F.x + (size_t)(128 * ck + 16 * F.wave) * D) + F.lane;
#pragma unroll
          for (int j = 0; j < 4; ++j) vn[j] = xr[64 * j]; }
#pragma unroll 1
        for (int r = 0; r < 16; ++r) {
            const int row = 128 * ck + 16 * F.wave + r;
            f32x4 v[4]; float s = 0.f;
#pragma unroll
            for (int j = 0; j < 4; ++j) { v[j] = vn[j]; s += (v[j].x * v[j].x + v[j].y * v[j].y) + (v[j].z * v[j].z + v[j].w * v[j].w); }
            { const GAS f32x4* xr = (const GAS f32x4*)(F.x + (size_t)(row + (r < 15 ? 1 : 0)) * D) + F.lane;
#pragma unroll
              for (int j = 0; j < 4; ++j) vn[j] = xr[64 * j]; }
            const float rstd = 1.0f / sqrtf(wave_sum(s) * (1.0f / D) + EPS);
            float d[8] = {0.f, 0.f, 0.f, 0.f, 0.f, 0.f, 0.f, 0.f};
            GAS unsigned long long* o8 = (GAS unsigned long long*)(F.XN + (size_t)row * D) + F.lane;
#pragma unroll
            for (int j = 0; j < 4; ++j) { v[j] = v[j] * rstd * gv[j];
                o8[64 * j] = (unsigned long long)pk2(v[j].x, v[j].y) | ((unsigned long long)pk2(v[j].z, v[j].w) << 32);
#pragma unroll
                for (int i = 0; i < 4; ++i) {
#pragma unroll
                    for (int hh = 0; hh < 4; ++hh) { d[hh] += v[j][i] * wf[j][i][0][hh]; d[4 + hh] += v[j][i] * wf[j][i][1][hh]; } } }
#pragma unroll
            for (int hh = 0; hh < 8; ++hh) d[hh] = wave_sum(d[hh]);
            float mine = d[0];
#pragma unroll
            for (int hh = 1; hh < 8; ++hh) mine = (hsel == hh) ? d[hh] : mine;
            pref += log_sigmoid_f(mine + bfv);
            if (F.lane < 8) SCAN[(16 * F.wave + r) * 8 + F.lane] = pref;
        }
        if (F.lane < 8) WTOT[F.wave * 8 + F.lane] = pref;
        __syncthreads();
#pragma unroll
        for (int q = 0; q < 2; ++q) { const int idx = F.tid + 512 * q, rr = idx >> 3, hh = idx & 7, w2 = rr >> 4; float off = 0.f;
            for (int w = 0; w < w2; ++w) off += WTOT[w * 8 + hh];
            F.LPRE[(size_t)(128 * ck + rr) * 8 + hh] = SCAN[idx] + off; }
        if (F.tid < 8) { float tot = 0.f; for (int w = 0; w < 8; ++w) tot += WTOT[w * 8 + F.tid]; F.CHT[ck * 8 + F.tid] = tot; }
        __syncthreads();
    }
}

__device__ __forceinline__ void p2_conv_prep(Frame& F, int reps) {
    typedef float f32x2v __attribute__((ext_vector_type(2)));
    LAS unsigned char* UT = F.lds + RING_OFF;
    LAS float* CT = (LAS float*)(F.lds + RING_OFF + 62 * 512 * 2);
    constexpr int NIT = M / 32;
    const int cp = F.tid & 255, half = F.tid >> 8;
    f32x2v w[CK];
#pragma unroll
    for (int j = 0; j < CK; ++j) w[j] = *(const GAS f32x2v*)(F.conv_dw_w + j * CW + 2 * cp);
    const f32x2v bdw = *(const GAS f32x2v*)(F.conv_dw_b + 2 * cp);
    f32x4 lg[2], lb[2];
#pragma unroll
    for (int q = 0; q < 2; ++q) { lg[q] = *(const GAS f32x4*)(F.conv_ln_g + 8 * F.lane + 4 * q); lb[q] = *(const GAS f32x4*)(F.conv_ln_b + 8 * F.lane + 4 * q); }
    for (int rep = 0; rep < reps; ++rep)
    for (int it = F.vcu; it < NIT; it += F.G) {
        const int b = it / (T / 32), t0 = (it % (T / 32)) * 32;
        for (int vv = F.tid; vv < 62 * 64; vv += 512) { const int rr = vv >> 6, cv = vv & 63, tt = t0 - 30 + rr;
            v4u val = (v4u){0u, 0u, 0u, 0u};
            if (tt >= 0) val = *(const GAS v4u*)(F.UB + ((size_t)(b * T + tt) * CW + cv * 8));
            *(LAS v4u*)(UT + (size_t)vv * 16) = val; }
        __syncthreads();
#pragma unroll 1
        for (int blk = 0; blk < 2; ++blk) { const int ob = 16 * half + 8 * blk;
            f32x2v win[38];
#pragma unroll
            for (int i = 0; i < 38; ++i) { const unsigned pk = *(const LAS unsigned*)(UT + ((ob + i) * CW + 2 * cp) * 2); win[i] = (f32x2v){__uint_as_float(pk << 16), __uint_as_float(pk & 0xffff0000u)}; }
            f32x2v acc[8];
#pragma unroll
            for (int i = 0; i < 8; ++i) acc[i] = bdw;
#pragma unroll
            for (int j = 0; j < CK; ++j)
#pragma unroll
                for (int i = 0; i < 8; ++i) acc[i] += w[j] * win[i + j];
#pragma unroll
            for (int i = 0; i < 8; ++i) *(LAS f32x2v*)(CT + (ob + i) * CW + 2 * cp) = acc[i]; }
        __syncthreads();
#pragma unroll 1
        for (int q = 0; q < 4; ++q) { const int rr = 4 * F.wave + q;
            f32x4 v0 = *(const LAS f32x4*)(CT + rr * CW + 8 * F.lane), v1 = *(const LAS f32x4*)(CT + rr * CW + 8 * F.lane + 4);
            const float mean = wave_sum((v0.x + v0.y) + (v0.z + v0.w) + (v1.x + v1.y) + (v1.z + v1.w)) * (1.0f / CW);
            v0 = v0 - mean; v1 = v1 - mean;
            const float var = wave_sum((v0.x * v0.x + v0.y * v0.y) + (v0.z * v0.z + v0.w * v0.w) + (v1.x * v1.x + v1.y * v1.y) + (v1.z * v1.z + v1.w * v1.w)) * (1.0f / CW);
            const float rstd = 1.0f / sqrtf(var + EPS);
            v0 = v0 * rstd * lg[0] + lb[0]; v1 = v1 * rstd * lg[1] + lb[1];
#pragma unroll
            for (int e = 0; e < 4; ++e) { v0[e] *= pg8::sigmoid_f(v0[e]); v1[e] *= pg8::sigmoid_f(v1[e]); }
            v4u o; o.x = pk2(v0.x, v0.y); o.y = pk2(v0.z, v0.w); o.z = pk2(v1.x, v1.y); o.w = pk2(v1.z, v1.w);
            *(GAS v4u*)(F.UC + ((size_t)(it * 32 + rr) * CW + 8 * F.lane)) = o; }
        __syncthreads();
    }
}
__device__ __forceinline__ void p7_final_norm(Frame& F) {
    const int gw = F.vcu * NWAVES + F.wave, NGW = F.G * NWAVES;
    f32x4 gv[4];
#pragma unroll
    for (int j = 0; j < 4; ++j) gv[j] = *(const GAS f32x4*)(F.norm_final_g + 4 * F.lane + 256 * j);
    for (int m = gw; m < M; m += NGW) {
        GAS f32x4* xr = (GAS f32x4*)(F.out + (size_t)m * D) + F.lane;
        const f32x4 p = *(const GAS f32x4*)(F.SSQ2 + (size_t)m * 4);
        const float rstd = 1.0f / sqrtf(((p.x + p.y) + (p.z + p.w)) * (1.0f / D) + EPS);
        f32x4 v[4];
#pragma unroll
        for (int j = 0; j < 4; ++j) v[j] = xr[64 * j];
#pragma unroll
        for (int j = 0; j < 4; ++j) xr[64 * j] = v[j] * rstd * gv[j];
    }
}
#ifndef MK_DUP
#define MK_DUP -1
#endif
__device__ __forceinline__ void phase_1(Frame& F) {
    pg8::Gemm g{F.XN, F.WIN_t, M, NPROJ, D}; pg8::StaticOrder S; S.init(M, NPROJ, F.G, (int)blockIdx.x);
    pg8::EpiInProj E{F.QB, (size_t)(WS_K - WS_Q) / 2, F.UB, attn_body::C2};
    pg8::gemm_phase<pg8::EpiInProj, pg8::StaticOrder, PG8_ALIGN, PG8_SP2>(F.lds + RING_OFF, g, S, E);
}
__device__ __forceinline__ void phase_2(Frame& F, char* lds) {
    p2_conv_prep(F, (MK_DUP == 20) ? 2 : 1);
    static_assert(attn_body::ATTN_LDS_BYTES <= RING_BYTES && attn_body::ATTN_PITCH == AW, "attention body geometry vs frame");
    const attn_body::AttnTensors AT{(const attn_body::bf16*)F.QB, (const attn_body::bf16*)F.KB, (const attn_body::bf16*)F.VB, (attn_body::bf16*)F.CAT, F.LPRE, F.CHT, F.attn_out_g};
    const attn_body::StaticOrder S((int)F.G, F.vcu);
    attn_body::attn_phase<8>(lds + RING_OFF, AT, S, (MK_DUP == 21) ? 2 : 1);
}
__device__ __forceinline__ void phase_3(Frame& F) {
    pg8::Gemm g{F.UC, F.WPW_t, M, CW, CW}; pg8::StaticOrder S; S.init(M, CW, F.G, (int)blockIdx.x);
    pg8::EpiConvOut E{F.CAT, F.b_conv_pw, F.conv_out_g, EPS};
    if (F.G >= (M / 256) * (CW / 256)) pg8::gemm_phase<pg8::EpiConvOut, pg8::StaticOrder, false, PG8_SP2>(F.lds + RING_OFF, g, S, E);
}
__device__ __forceinline__ void phase_4(Frame& F, LAS float* scr_tab) {
    pg8::Gemm g{F.CAT, F.WOUT_t, M, D, D}; pg8::StaticOrder S; S.init(M, D, F.G, (int)blockIdx.x);
    pg8::EpiRes<0> E{F.x, nullptr, nullptr, F.XN, F.SSQ1, nullptr, scr_tab, EPS};
    pg8::gemm_phase<pg8::EpiRes<0>, pg8::StaticOrder, true, PG8_SP2>(F.lds + RING_OFF, g, S, E);
}
__device__ __forceinline__ void phase_5(Frame& F) {
    pg8::Gemm g{F.XN, F.WUP_t, M, FF, D}; pg8::StaticOrder S; S.init(M, FF, F.G, (int)blockIdx.x);
    pg8::EpiRelu2 E{F.HB, FF};
    pg8::gemm_phase<pg8::EpiRelu2, pg8::StaticOrder, PG8_ALIGN, PG8_SP2>(F.lds + RING_OFF, g, S, E);
}
__device__ __forceinline__ void phase_6(Frame& F, LAS float* scr_tab) {
    pg8::Gemm g{F.HB, F.WDN_t, M, D, FF}; pg8::StaticOrder S; S.init(M, D, F.G, (int)blockIdx.x);
    pg8::EpiRes<1> E{nullptr, F.XN, F.out, nullptr, F.SSQ2, F.SSQ1, scr_tab, EPS};
    pg8::gemm_phase<pg8::EpiRes<1>, pg8::StaticOrder, true, PG8_SP2>(F.lds + RING_OFF, g, S, E);
}
struct Args { const float* in[17]; float* out; unsigned char* ws; int ph_lo, ph_hi, li, pad; };
__global__ void __launch_bounds__(NWAVES * 64, 2) mk_fwd(Args args) {
    extern __shared__ __attribute__((aligned(16))) unsigned char lds[];
    Frame F;
    F.lds = (LAS unsigned char*)lds;
    F.MISC = (volatile LAS unsigned*)(F.lds + MISC_OFF);
    F.tid = threadIdx.x; F.lane = F.tid & 63; F.wave = __builtin_amdgcn_readfirstlane(F.tid >> 6);
    F.G = gridDim.x; { const int bx = blockIdx.x; F.vcu = (F.G % 8 == 0) ? (bx % 8) * (F.G / 8) + bx / 8 : bx; }
#define GRID_BAR(seam) do { if (N_LAUNCHES == PER_PHASE) { if (F.tid == 0) __hip_atomic_store(F.ctl + CW_TMO, 0xBADBA0u | (unsigned)(seam), RLX_AGENT); } \
    else { xcd_barrier(bar); } } while (0)
    unsigned char* ws = args.ws;
    F.ctl = (gu32*)(ws + WS_CTL);
    F.x = args.in[0]; F.norm_mix_g = args.in[1]; F.w_in = args.in[2]; F.b_forget = args.in[3]; F.conv_dw_w = args.in[4]; F.conv_dw_b = args.in[5]; F.conv_ln_g = args.in[6]; F.conv_ln_b = args.in[7];
    F.w_conv_pw = args.in[8]; F.b_conv_pw = args.in[9]; F.attn_out_g = args.in[10]; F.conv_out_g = args.in[11]; F.w_out = args.in[12]; F.norm_ffn_g = args.in[13]; F.w_up = args.in[14]; F.w_dn = args.in[15];
    F.norm_final_g = args.in[16]; F.out = args.out;
    F.WIN_t = (bf16*)(ws + WS_WIN); F.WPW_t = (bf16*)(ws + WS_WPW); F.WOUT_t = (bf16*)(ws + WS_WOUT); F.WUP_t = (bf16*)(ws + WS_WUP); F.WDN_t = (bf16*)(ws + WS_WDN);
    F.XN = (bf16*)(ws + WS_XN); F.QB = (bf16*)(ws + WS_Q); F.KB = (bf16*)(ws + WS_K); F.VB = (bf16*)(ws + WS_V); F.UB = (bf16*)(ws + WS_U); F.UC = (bf16*)(ws + WS_UC); F.CAT = (bf16*)(ws + WS_CAT); F.HB = (bf16*)(ws + WS_H);
    F.LPRE = (float*)(ws + WS_LPRE); F.CHT = (float*)(ws + WS_CHT); F.SSQ1 = (float*)(ws + WS_SSQ1); F.SSQ2 = (float*)(ws + WS_SSQ2);
    for (int u = F.tid; u < (LDS_BYTES - LDSCTL_OFF) / 4; u += NWAVES * 64) ((LAS unsigned*)(F.lds + LDSCTL_OFF))[u] = 0u;
    __syncthreads();
    XcdBarrier bar; bar.bar = (unsigned*)(F.ctl + CW_BAR); bar.x = 0; bar.st = nullptr;
    if (N_LAUNCHES != PER_PHASE) bar = xcd_barrier_post((unsigned*)(F.ctl + CW_BAR), F.MISC + 8);
    const int lo = args.ph_lo, hi = args.ph_hi;
#define IN(k) (lo <= (k) && (k) < hi)
#define BOTH(k) (IN(k) && IN((k) + 1))
    LAS float* const scr_tab = (LAS float*)(F.lds + SCR_OFF);

#define RUN(k, CALL) if (IN(k)) { CALL; if (BOTH(k)) GRID_BAR(k); if (MK_DUP == (k)) { CALL; if (BOTH(k)) GRID_BAR(k); } }
    RUN(0, p0_prologue(F));
    RUN(1, phase_1(F));
    RUN(2, phase_2(F, (char*)lds));
    RUN(3, phase_3(F));
    RUN(4, phase_4(F, scr_tab));
    RUN(5, phase_5(F));
    RUN(6, phase_6(F, scr_tab));
#undef RUN

    if (IN(7)) {
        unsigned poison = (__hip_atomic_load(F.ctl + CW_TMO, RLX_AGENT) != 0u) | (__hip_atomic_load((gu32*)((const unsigned*)(F.ctl + CW_BAR) + XB_TMO), RLX_AGENT) != 0u);
        p7_final_norm(F);
        if (poison) { const int gw = F.vcu * NWAVES + F.wave, NGW = F.G * NWAVES; const float q = __builtin_nanf("");
            for (int m = gw; m < M; m += NGW) { GAS f32x4* o = (GAS f32x4*)(F.out + (size_t)m * D) + F.lane;
#pragma unroll
                for (int j = 0; j < 4; ++j) o[64 * j] = (f32x4){q, q, q, q}; } }
    }
#undef IN
#undef BOTH
}

extern "C" void kernel_launch(void* const* d_in, const int* in_sizes, int n_in, void* d_out, int out_size, void* d_ws, size_t ws_size, hipStream_t stream) {
    static int grid = 0;
    if (grid == 0) {
        if (n_in != 17 || in_sizes[0] != M * D || out_size != M * D || ws_size < WS_END) { fprintf(stderr, "kernel_launch: built for 17 inputs, x and out of %d floats, >= %zu bytes of workspace; got n_in %d, in0 %d, out %d, ws %zu; nothing launched\n", M * D, (size_t)WS_END, n_in, n_in > 0 ? in_sizes[0] : -1, out_size, ws_size); grid = -1; return; }
        int dev = 0, cus = 0, per_cu = 0;
        if (hipGetDevice(&dev) != hipSuccess || hipDeviceGetAttribute(&cus, hipDeviceAttributeMultiprocessorCount, dev) != hipSuccess) { fprintf(stderr, "kernel_launch: hipGetDevice / hipDeviceGetAttribute failed\n"); grid = -1; return; }
        if (hipFuncSetAttribute((const void*)mk_fwd, hipFuncAttributeMaxDynamicSharedMemorySize, LDS_BYTES) != hipSuccess) { fprintf(stderr, "kernel_launch: hipFuncSetAttribute failed\n"); grid = -1; return; }
        if (hipOccupancyMaxActiveBlocksPerMultiprocessor(&per_cu, (const void*)mk_fwd, NWAVES * 64, LDS_BYTES) != hipSuccess || per_cu < 1)
            fprintf(stderr, "kernel_launch: note: the occupancy query reports %d workgroups per CU\n", per_cu);
        (void)hipGetLastError();
        grid = cus;
        if (grid > 256) grid = 256;
    }
    if (grid < 0) return;
    if (hipMemsetAsync((char*)d_ws + WS_CTL, 0, CTL_ZERO_BYTES, stream) != hipSuccess) { fprintf(stderr, "kernel_launch: hipMemsetAsync failed\n"); return; }
    Args a{};
    for (int i = 0; i < 17; ++i) a.in[i] = (const float*)d_in[i];
    a.out = (float*)d_out; a.ws = (unsigned char*)d_ws;
    for (int li = 0; li < N_LAUNCHES; ++li) {
        a.ph_lo = (N_LAUNCHES == PER_PHASE) ? li : 0; a.ph_hi = (N_LAUNCHES == PER_PHASE) ? li + 1 : PER_PHASE; a.li = li;
        hipLaunchKernelGGL(mk_fwd, dim3(grid), dim3(NWAVES * 64), LDS_BYTES, stream, a);
        const hipError_t le = hipPeekAtLastError();
        if (le != hipSuccess) { fprintf(stderr, "kernel_launch: launch %d failed: %s\n", li, hipGetErrorName(le)); break; }
    }
}
```
